# Optimizing an MI355X kernel written in HIP

```python
import jax
import jax.numpy as jnp
from jax import lax
import numpy as np

D_MODEL = 1024
BATCH = 16
SEQ = 4096
DEPTH = 4
DEC_BATCH = 16
DEC_SEQ = 16
PAST_LEN = 4096

CHUNK = 64
SUB_BLOCK = 16
QBLOCK = 128
N_A = DEPTH // 2
N_B = DEPTH - N_A
MIX_WIDTH = D_MODEL
MEM_WIDTH = D_MODEL // 4
MAIN_WIDTH = MIX_WIDTH - MEM_WIDTH
HG_DK = 128
HG_DV = 128
HG_HEADS = MAIN_WIDTH // HG_DK
FOX_HD = 64
FOX_HEADS = MAIN_WIDTH // FOX_HD
MEM_HEADS = 4
MEM_HD = MEM_WIDTH // MEM_HEADS
N_MEM = 256
D_FF = -(-(8 * D_MODEL) // (3 * 256)) * 256
A_IN = 4 * MAIN_WIDTH + MEM_WIDTH
B_IN = MAIN_WIDTH + MEM_WIDTH
KV_OUT = 2 * MAIN_WIDTH + FOX_HEADS
EPS = 1e-6
K_MAX = 0.999999
FOX_F_BIAS = 3.0
NEG = -1e30

kernel_name = "yoco_hgrn2_fox_stream_step"


def _rms_norm(x, g):
    xf = x.astype(jnp.float32)
    y = xf * lax.rsqrt(jnp.mean(xf * xf, axis=-1, keepdims=True) + EPS)
    return (y * g.astype(jnp.float32)).astype(x.dtype)


def _hgrn_chunk_step(s, inp):
    q, k, v, g = inp
    bsz, h, c, dk = q.shape
    ns = c // SUB_BLOCK
    b = jnp.cumsum(g, axis=2)
    o_inter = jnp.einsum("bhck,bhkv->bhcv", q * jnp.exp(b), s)
    qs = q.reshape(bsz, h, ns, SUB_BLOCK, dk)
    ks = k.reshape(bsz, h, ns, SUB_BLOCK, dk)
    bs = b.reshape(bsz, h, ns, SUB_BLOCK, dk)
    ref = jnp.concatenate([jnp.zeros_like(bs[:, :, :1, 0]), bs[:, :, :-1, -1]], axis=2)
    q_hat = qs * jnp.exp(bs - ref[:, :, :, None, :])
    e_off = jnp.minimum(ref[:, :, :, None, None, :] - bs[:, :, None, :, :, :], 0.0)
    k_hat = ks[:, :, None] * jnp.exp(e_off)
    a_off = jnp.einsum("bhitk,bhijsk->bhijts", q_hat, k_hat)
    e_diag = jnp.minimum(bs[:, :, :, :, None, :] - bs[:, :, :, None, :, :], 0.0)
    a_diag = jnp.einsum("bhitk,bhisk,bhitsk->bhits", qs, ks, jnp.exp(e_diag))
    eye = np.eye(ns, dtype=bool)[:, :, None, None]
    lower = np.tril(np.ones((ns, ns), dtype=bool), -1)[:, :, None, None]
    tri = np.tril(np.ones((SUB_BLOCK, SUB_BLOCK), dtype=bool))
    a = jnp.where(eye, jnp.where(tri, a_diag[:, :, :, None], 0.0), jnp.where(lower, a_off, 0.0))
    a = a.transpose(0, 1, 2, 4, 3, 5).reshape(bsz, h, c, c)
    o = o_inter + jnp.einsum("bhts,bhsv->bhtv", a, v)
    b_last = b[:, :, -1]
    s_new = jnp.exp(b_last)[..., None] * s + jnp.einsum(
        "bhck,bhcv->bhkv", k * jnp.exp(b_last[:, :, None] - b), v)
    return s_new, o


def _hgrn_recurrence(q, k, v, g, s0):
    bsz, t, h, _ = q.shape
    pad = (-t) % CHUNK
    n = (t + pad) // CHUNK

    def to_chunks(x):
        x = jnp.pad(x, ((0, 0), (0, pad), (0, 0), (0, 0)))
        return x.reshape(bsz, n, CHUNK, h, x.shape[-1]).transpose(1, 0, 3, 2, 4)

    s_fin, o = lax.scan(_hgrn_chunk_step, s0, (to_chunks(q), to_chunks(k), to_chunks(v), to_chunks(g)))
    o = o.transpose(1, 0, 3, 2, 4).reshape(bsz, n * CHUNK, h, -1)[:, :t]
    return o, s_fin


def _hgrn2_mixer(pq, pf, pi, pg, lb, gnorm, s0):
    bsz, t, _ = pq.shape
    shp = (bsz, t, HG_HEADS, HG_DK)
    q = jax.nn.silu(pq.astype(jnp.float32)).reshape(shp)
    z = pf.astype(jnp.float32).reshape(shp)
    lbh = lb.astype(jnp.float32).reshape(HG_HEADS, HG_DK)
    k = jnp.minimum((1.0 - lbh) * jax.nn.sigmoid(-z), K_MAX)
    log_f = jnp.log1p(-k)
    v = pi.astype(jnp.float32).reshape(bsz, t, HG_HEADS, HG_DV)
    o, s_fin = _hgrn_recurrence(q, k, v, log_f, s0.astype(jnp.float32))
    gate = jax.nn.silu(pg.astype(jnp.float32)).reshape(bsz, t, HG_HEADS, HG_DV)
    o = _rms_norm(o, gnorm) * gate
    return o.reshape(bsz, t, MAIN_WIDTH).astype(pq.dtype), s_fin


def _fox_block(q, k, v, c_q, c_k, t0):
    s = jnp.einsum("bqhd,bkhd->bhqk", q, k).astype(jnp.float32) * (FOX_HD ** -0.5)
    s = s + (jnp.swapaxes(c_q, 1, 2)[..., :, None] - jnp.swapaxes(c_k, 1, 2)[..., None, :])
    q_pos = t0 + jnp.arange(q.shape[1])
    k_pos = jnp.arange(k.shape[1])
    s = jnp.where(k_pos[None, :] <= q_pos[:, None], s, NEG)
    p = jax.nn.softmax(s, axis=-1)
    return jnp.einsum("bhqk,bkhd->bqhd", p.astype(v.dtype), v)


def _fox_attention(q, k_all, v_all, c_all, t0):
    bsz, t = q.shape[:2]
    if t % QBLOCK == 0:
        nb = t // QBLOCK
        qb = q.reshape(bsz, nb, QBLOCK, FOX_HEADS, FOX_HD).swapaxes(0, 1)
        cb = c_all[:, t0:].reshape(bsz, nb, QBLOCK, FOX_HEADS).swapaxes(0, 1)
        starts = t0 + QBLOCK * jnp.arange(nb)
        o = lax.map(lambda blk: _fox_block(blk[0], k_all, v_all, blk[1], c_all, blk[2]), (qb, cb, starts))
        o = o.swapaxes(0, 1)
    else:
        o = _fox_block(q, k_all, v_all, c_all[:, t0:], c_all, t0)
    return o.reshape(bsz, t, MAIN_WIDTH)


def _shared_kv(h, g_norm, w_kv, b_f, g_k):
    bsz, t, _ = h.shape
    p = _rms_norm(h, g_norm) @ w_kv
    k = _rms_norm(p[..., :MAIN_WIDTH].reshape(bsz, t, FOX_HEADS, FOX_HD), g_k)
    v = p[..., MAIN_WIDTH:2 * MAIN_WIDTH].reshape(bsz, t, FOX_HEADS, FOX_HD)
    logf = jax.nn.log_sigmoid((p[..., 2 * MAIN_WIDTH:] + b_f).astype(jnp.float32))
    return k, v, logf


def _memory_kv(mem, g_norm, w_kv, g_k):
    bsz, m, _ = mem.shape
    k, v = jnp.split(_rms_norm(mem, g_norm) @ w_kv, 2, axis=-1)
    k = _rms_norm(k.reshape(bsz, m, MEM_HEADS, MEM_HD), g_k)
    return k, v.reshape(bsz, m, MEM_HEADS, MEM_HD)


def _memory_attend(pm, g_q, mem_k, mem_v):
    bsz, t, _ = pm.shape
    q = _rms_norm(pm.reshape(bsz, t, MEM_HEADS, MEM_HD), g_q)
    s = jnp.einsum("bthd,bmhd->bhtm", q, mem_k).astype(jnp.float32) * (MEM_HD ** -0.5)
    p = jax.nn.softmax(s, axis=-1)
    o = jnp.einsum("bhtm,bmhd->bthd", p.astype(mem_v.dtype), mem_v)
    return o.reshape(bsz, t, MEM_WIDTH)


def _swiglu(h, g, w_up, w_down):
    gate, up = jnp.split(_rms_norm(h, g) @ w_up, 2, axis=-1)
    return (jax.nn.silu(gate) * up) @ w_down


def _trunk(x, mem_k, mem_v, hg_states, past, lower_bounds, prm):
    bsz, t, _ = x.shape
    h = x
    new_states = []
    shared = None
    new_kv = None
    for l in range(DEPTH):
        a = _rms_norm(h, prm["norm_mix"][l])
        if l < N_A:
            proj = a @ prm["w_in_a"][l]
            pq, pf, pi, pg, pm = jnp.split(
                proj, [MAIN_WIDTH, 2 * MAIN_WIDTH, 3 * MAIN_WIDTH, 4 * MAIN_WIDTH], axis=-1)
            o_main, s_new = _hgrn2_mixer(pq, pf, pi, pg, lower_bounds[l], prm["hg_gnorm"][l], hg_states[l])
            new_states.append(s_new)
        else:
            j = l - N_A
            proj = a @ prm["w_in_b"][j]
            pq, pm = jnp.split(proj, [MAIN_WIDTH], axis=-1)
            q = _rms_norm(pq.reshape(bsz, t, FOX_HEADS, FOX_HD), prm["fox_gq"][j])
            o_main = _fox_attention(q, shared[0], shared[1], shared[2], shared[3])
        o_mem = _memory_attend(pm, prm["mem_gq"][l], mem_k[l], mem_v[l])
        h = h + jnp.concatenate([o_main, o_mem], axis=-1) @ prm["w_out"][l]
        h = h + _swiglu(h, prm["norm_ffn"][l], prm["w_ffn_up"][l], prm["w_ffn_down"][l])
        if l == N_A - 1:
            k_new, v_new, logf_new = _shared_kv(h, prm["norm_kv"], prm["w_kv"], prm["b_f"], prm["fox_gk"])
            new_kv = (k_new, v_new, logf_new)
            if past is None:
                k_all, v_all, logf_all = k_new, v_new, logf_new
            else:
                k_all = jnp.concatenate([past[0], k_new.astype(past[0].dtype)], axis=1)
                v_all = jnp.concatenate([past[1], v_new.astype(past[1].dtype)], axis=1)
                logf_all = jnp.concatenate([past[2].astype(jnp.float32), logf_new], axis=1)
            c_all = jnp.cumsum(logf_all, axis=1)
            shared = (k_all, v_all, c_all, k_all.shape[1] - t)
    return h, new_states, new_kv


def setup_inputs(seed: int = 0) -> dict:
    key = jax.random.key(seed)
    ks = jax.random.split(key, 28)
    f32 = jnp.float32
    d = D_MODEL

    def nrm(k, shape, scale=1.0):
        return jax.random.normal(k, shape, f32) * scale

    def gain(k, shape):
        return 1.0 + 0.02 * jax.random.normal(k, shape, f32)

    return {
        "x_prompt": nrm(ks[0], (BATCH, SEQ, d)),
        "x_sample": nrm(ks[1], (DEC_BATCH, DEC_SEQ, d)),
        "mem_prompt": nrm(ks[2], (BATCH, N_MEM, d)),
        "state_hgrn_0": nrm(ks[3], (DEC_BATCH, HG_HEADS, HG_DK, HG_DV), 0.5),
        "state_hgrn_1": nrm(ks[4], (DEC_BATCH, HG_HEADS, HG_DK, HG_DV), 0.5),
        "cache_fox_k": nrm(ks[5], (DEC_BATCH, PAST_LEN, FOX_HEADS, FOX_HD)),
        "cache_fox_v": nrm(ks[6], (DEC_BATCH, PAST_LEN, FOX_HEADS, FOX_HD)),
        "cache_fox_logf": jax.nn.log_sigmoid(FOX_F_BIAS + nrm(ks[7], (DEC_BATCH, PAST_LEN, FOX_HEADS))),
        "cache_mem_k": nrm(ks[8], (DEPTH, DEC_BATCH, N_MEM, MEM_HEADS, MEM_HD)),
        "cache_mem_v": nrm(ks[9], (DEPTH, DEC_BATCH, N_MEM, MEM_HEADS, MEM_HD)),
        "norm_mix": gain(ks[10], (DEPTH, d)),
        "w_in_a": nrm(ks[11], (N_A, d, A_IN), d ** -0.5),
        "lb_logits": nrm(ks[12], (N_A, MAIN_WIDTH), 0.1),
        "hg_gnorm": gain(ks[13], (N_A, HG_DV)),
        "w_in_b": nrm(ks[14], (N_B, d, B_IN), d ** -0.5),
        "fox_gq": gain(ks[15], (N_B, FOX_HD)),
        "norm_kv": gain(ks[16], (d,)),
        "w_kv": nrm(ks[17], (d, KV_OUT), d ** -0.5),
        "b_f": FOX_F_BIAS + nrm(ks[18], (FOX_HEADS,), 0.5),
        "fox_gk": gain(ks[19], (FOX_HD,)),
        "norm_mem": gain(ks[20], (DEPTH, d)),
        "w_mem_kv": nrm(ks[21], (DEPTH, d, 2 * MEM_WIDTH), d ** -0.5),
        "mem_gq": gain(ks[22], (DEPTH, MEM_HD)),
        "mem_gk": gain(ks[23], (DEPTH, MEM_HD)),
        "w_out": nrm(ks[24], (DEPTH, MIX_WIDTH, d), (2 * DEPTH * MIX_WIDTH) ** -0.5),
        "norm_ffn": gain(ks[25], (DEPTH, d)),
        "w_ffn_up": nrm(ks[26], (DEPTH, d, 2 * D_FF), d ** -0.5),
        "w_ffn_down": nrm(ks[27], (DEPTH, D_FF, d), (2 * DEPTH * D_FF) ** -0.5),
    }


def reference(x_prompt, x_sample, mem_prompt, state_hgrn_0, state_hgrn_1, cache_fox_k, cache_fox_v,
              cache_fox_logf, cache_mem_k, cache_mem_v, norm_mix, w_in_a, lb_logits, hg_gnorm, w_in_b,
              fox_gq, norm_kv, w_kv, b_f, fox_gk, norm_mem, w_mem_kv, mem_gq, mem_gk, w_out, norm_ffn,
              w_ffn_up, w_ffn_down):
    prm = {
        "norm_mix": norm_mix, "w_in_a": w_in_a, "hg_gnorm": hg_gnorm, "w_in_b": w_in_b,
        "fox_gq": fox_gq, "norm_kv": norm_kv, "w_kv": w_kv, "b_f": b_f, "fox_gk": fox_gk,
        "mem_gq": mem_gq, "w_out": w_out, "norm_ffn": norm_ffn, "w_ffn_up": w_ffn_up,
        "w_ffn_down": w_ffn_down,
    }
    p_lb = jax.nn.softmax(lb_logits.astype(jnp.float32), axis=0)
    lower_bounds = jnp.cumsum(p_lb, axis=0) - p_lb[0]

    mk, mv = [], []
    for l in range(DEPTH):
        k_l, v_l = _memory_kv(mem_prompt, norm_mem[l], w_mem_kv[l], mem_gk[l])
        mk.append(k_l)
        mv.append(v_l)
    p_mem_k = jnp.stack(mk)
    p_mem_v = jnp.stack(mv)
    s_zero = jnp.zeros((x_prompt.shape[0], HG_HEADS, HG_DK, HG_DV), jnp.float32)
    y_prompt, p_states, p_kv = _trunk(x_prompt, p_mem_k, p_mem_v, [s_zero] * N_A, None, lower_bounds, prm)

    y_sample, s_states, s_kv = _trunk(x_sample, cache_mem_k, cache_mem_v, [state_hgrn_0, state_hgrn_1],
                                      (cache_fox_k, cache_fox_v, cache_fox_logf), lower_bounds, prm)
    return (y_prompt, y_sample, p_states[0], p_states[1], p_kv[0], p_kv[1], p_kv[2], p_mem_k, p_mem_v,
            s_states[0], s_states[1], s_kv[0], s_kv[1], s_kv[2])
```

```cpp
#include <hip/hip_runtime.h>
#include <hip/hip_cooperative_groups.h>
#include <cstdio>
namespace cg = cooperative_groups;

#define LAS __attribute__((address_space(3)))
typedef unsigned short bf16_t;
typedef short bf16x8 __attribute__((ext_vector_type(8)));
typedef float f32x4 __attribute__((ext_vector_type(4)));
typedef float f32x2 __attribute__((ext_vector_type(2)));
typedef float f32x16 __attribute__((ext_vector_type(16)));
typedef unsigned u32x4 __attribute__((ext_vector_type(4)));
typedef unsigned u32x2 __attribute__((ext_vector_type(2)));

constexpr int NB = 16, TP = 4096, TS = 16;
constexpr int MPR = NB * TP;
constexpr int MSR = NB * TS;
constexpr int MT = MPR + MSR;
constexpr int MR = MT + 64;
constexpr int LS = 4128;
constexpr float EPS = 1e-6f, KMAX = 0.999999f, LOG2E = 1.4426950408889634f, QSCALE = 0.125f * 1.4426950408889634f;

constexpr size_t O_YP = 0, O_YS = 67108864, O_PST0 = 67371008, O_PST1 = 68943872, O_PFK = 70516736, O_PFV = 120848384,
                 O_PFL = 171180032, O_PMK = 171966464, O_PMV = 176160768, O_SST0 = 180355072, O_SST1 = 181927936,
                 O_SFK = 183500800, O_SFV = 183697408, O_SFL = 183894016;
constexpr size_t DO_OMIX = 0, DO_QB = 134873088, DO_ACT01 = O_PFK * 4;

constexpr size_t SZ_W1K = 2097152;
constexpr size_t SZ_WUP = 11534336, SZ_WDN = 5767168, SZ_WINA = 6815744, SZ_WKV = 3670016, SZ_WMEM = 4194304;
constexpr size_t OFF_WINB = 0;
constexpr size_t OFF_WOUT23 = OFF_WINB + 2 * SZ_W1K;
constexpr size_t OFF_WUP23 = OFF_WOUT23 + 2 * SZ_W1K;
constexpr size_t OFF_WDN23 = OFF_WUP23 + 2 * SZ_WUP;
constexpr size_t OFF_H = OFF_WDN23 + 2 * SZ_WDN;
constexpr size_t SZ_H = (size_t)MR * 1024 * 2;
constexpr size_t OFF_RS = OFF_H + SZ_H;
constexpr size_t SZ_RS = (size_t)MR * 16 * 4;
constexpr size_t SZ_MEMKV = 8388608;
constexpr size_t OFF_MEMK_P = OFF_RS + SZ_RS, OFF_MEMVT_P = OFF_MEMK_P + SZ_MEMKV, OFF_MEMK_S = OFF_MEMVT_P + SZ_MEMKV, OFF_MEMVT_S = OFF_MEMK_S + SZ_MEMKV;
constexpr size_t SZ_KP = (size_t)NB * 4096 * 768 * 2, SZ_KS = (size_t)NB * LS * 768 * 2;
constexpr size_t OFF_KBUF_P = OFF_MEMVT_S + SZ_MEMKV, OFF_KBUF_S = OFF_KBUF_P + SZ_KP, OFF_VT_P = OFF_KBUF_S + SZ_KS, OFF_VT_S = OFF_VT_P + SZ_KP;
constexpr size_t OFF_C_P = OFF_VT_S + SZ_KS;
constexpr size_t OFF_C_S = OFF_C_P + (size_t)NB * 12 * 4096 * 4;
constexpr size_t OFF_OML = OFF_C_S + (size_t)NB * 12 * LS * 4;
constexpr size_t OFF_CTR = OFF_OML + 8192;
constexpr size_t OFF_XBAR = OFF_CTR + 256;
constexpr size_t OFF_ACTW = OFF_XBAR + 16384;
constexpr size_t SZ_ACT = (size_t)MR * 2816 * 2;
constexpr size_t SZ_X768 = (size_t)MR * 768 * 2;
constexpr size_t OFF_GB = OFF_ACTW;
constexpr size_t OFF_WINA = OFF_GB + (size_t)MR * 768 * 4;
constexpr size_t OFF_WKV = OFF_WINA + 2 * SZ_WINA;
constexpr size_t OFF_WMEM = OFF_WKV + SZ_WKV;
constexpr size_t OFF_WOUT01 = OFF_WMEM + SZ_WMEM;
constexpr size_t OFF_WUP01 = OFF_WOUT01 + 2 * SZ_W1K;
constexpr size_t OFF_WDN01 = OFF_WUP01 + 2 * SZ_WUP;
constexpr size_t OFF_MEMB = OFF_WDN01 + 2 * SZ_WDN;
constexpr size_t OFF_RSMEM = OFF_MEMB + 8388608;
constexpr size_t OFF_EARLY_END = OFF_RSMEM + 262144;
constexpr size_t OFF_PMQ = OFF_ACTW + SZ_ACT;
constexpr size_t WS_END = OFF_PMQ + (size_t)MR * 256 * 2;
static_assert(OFF_EARLY_END <= OFF_ACTW + SZ_ACT, "overlay overflow");
static_assert(WS_END <= (size_t)1073741824, "workspace too large");
constexpr size_t OFF_VB = OFF_KBUF_P, OFF_GATEB = OFF_VB + SZ_X768;
static_assert(OFF_GATEB + SZ_X768 <= OFF_C_P, "A-layer overlay overflow");
static_assert(DO_QB + SZ_X768 <= (size_t)O_YS * 4, "y scratch overflow");
static_assert(DO_ACT01 + SZ_ACT <= (size_t)O_PFL * 4, "act scratch overflow");

constexpr int NG = 24;
constexpr int LDS_BYTES = 131072 + 4096 + 256;

struct WJob { const float* W; const float* gain; bf16_t* Bt; int K, Ntrue, Np, kind; };
struct Params {
    const float* in[28];
    float* out;
    unsigned char* ws;
    WJob wj[21];
};

__device__ __forceinline__ unsigned pk_bf16(float lo, float hi) { unsigned r; asm("v_cvt_pk_bf16_f32 %0, %1, %2" : "=v"(r) : "v"(lo), "v"(hi)); return r; }
__device__ __forceinline__ int otid() { int t = threadIdx.x; asm volatile("" : "+v"(t)); return t; }
__device__ __forceinline__ unsigned xb_ld(unsigned* p)              { return __hip_atomic_load(p, __ATOMIC_RELAXED, __HIP_MEMORY_SCOPE_AGENT); }
__device__ __forceinline__ unsigned xb_add(unsigned* p, unsigned v) { return __hip_atomic_fetch_add(p, v, __ATOMIC_RELAXED, __HIP_MEMORY_SCOPE_AGENT); }
__device__ __forceinline__ float bf_lo(unsigned u) { return __uint_as_float(u << 16); }
__device__ __forceinline__ float bf_hi(unsigned u) { return __uint_as_float(u & 0xffff0000u); }
__device__ __forceinline__ float silu_f(float x) { return x * __builtin_amdgcn_rcpf(1.0f + __expf(-x)); }
__device__ __forceinline__ float lanex(float x, int src) { return __int_as_float(__builtin_amdgcn_ds_bpermute(src << 2, __float_as_int(x))); }
#define xor16(x) lanex((x), lane ^ 16)
#define xor32(x) lanex((x), lane ^ 32)
__device__ __forceinline__ bf16_t* wsb(const Params& P, size_t off) { return (bf16_t*)(P.ws + off); }
__device__ __forceinline__ float* wsf(const Params& P, size_t off) { return (float*)(P.ws + off); }
__device__ __forceinline__ bf16_t* outb(const Params& P, size_t off) { return (bf16_t*)((unsigned char*)P.out + off); }
__device__ __forceinline__ const bf16_t* w_out_ptr(const Params& P, int l) { return l < 2 ? wsb(P, OFF_WOUT01 + l * SZ_W1K) : wsb(P, OFF_WOUT23 + (l - 2) * SZ_W1K); }
__device__ __forceinline__ const bf16_t* w_up_ptr(const Params& P, int l) { return l < 2 ? wsb(P, OFF_WUP01 + l * SZ_WUP) : wsb(P, OFF_WUP23 + (l - 2) * SZ_WUP); }
__device__ __forceinline__ const bf16_t* w_dn_ptr(const Params& P, int l) { return l < 2 ? wsb(P, OFF_WDN01 + l * SZ_WDN) : wsb(P, OFF_WDN23 + (l - 2) * SZ_WDN); }
__device__ __forceinline__ bf16_t* act_ptr(const Params& P, int l) { return l < 2 ? outb(P, DO_ACT01) : wsb(P, OFF_ACTW); }

__device__ __forceinline__ int colmap(int kind, int n) {
    const int head = (n & ~255) + (((n >> 5) & 3) << 6) + (((n >> 7) & 1) << 5) + (n & 31);
    switch (kind) {
        case 0: return n;
        case 1: return head;
        case 2: return n < 3072 ? n : head;
        case 3: { const int pn = n >> 8, tc = n & 255; return (tc >> 7) * 2816 + pn * 128 + (tc & 127); }
        case 4: return n < 768 ? head : n;
        default: return n < 256 ? head : n;
    }
}

__device__ void prep_weights(const Params& P, LAS unsigned char* lds) {
    LAS bf16_t* tile = (LAS bf16_t*)lds;
    const int tid = otid();
    for (int j = 0; j < 21; ++j) {
        const float* W = P.wj[j].W; const float* gain = P.wj[j].gain; bf16_t* Bt = P.wj[j].Bt;
        const int K = P.wj[j].K, Ntrue = P.wj[j].Ntrue, Np = P.wj[j].Np, kind = P.wj[j].kind;
        const int ntn = Np >> 6, nt = ntn * (K >> 6);
        for (int t = blockIdx.x; t < nt; t += gridDim.x) {
            const int n0 = (t % ntn) << 6, k0 = (t / ntn) << 6;
            {
                const int kk = tid >> 3, nc = (tid & 7) << 3;
                const int col = colmap(kind, n0 + nc);
                const float gk = gain ? gain[k0 + kk] : 1.0f;
                const float* src = W + (size_t)(k0 + kk) * Ntrue + col;
                float x[8];
                if (col + 8 <= Ntrue) { const f32x4 a = *(const f32x4*)src, b = *(const f32x4*)(src + 4);
                    x[0] = a[0]; x[1] = a[1]; x[2] = a[2]; x[3] = a[3]; x[4] = b[0]; x[5] = b[1]; x[6] = b[2]; x[7] = b[3]; }
                else {
#pragma unroll
                    for (int i = 0; i < 8; ++i) x[i] = (col + i < Ntrue) ? src[i] : 0.0f; }
                u32x4 w; w.x = pk_bf16(x[0] * gk, x[1] * gk); w.y = pk_bf16(x[2] * gk, x[3] * gk); w.z = pk_bf16(x[4] * gk, x[5] * gk); w.w = pk_bf16(x[6] * gk, x[7] * gk);
                *(LAS u32x4*)(tile + kk * 72 + nc) = w;
            }
            __syncthreads();
            {
                const int nn = tid >> 3, kc = (tid & 7) << 3;
                unsigned short e[8];
#pragma unroll
                for (int i = 0; i < 8; ++i) e[i] = tile[(kc + i) * 72 + nn];
                u32x4 w; w.x = e[0] | ((unsigned)e[1] << 16); w.y = e[2] | ((unsigned)e[3] << 16); w.z = e[4] | ((unsigned)e[5] << 16); w.w = e[6] | ((unsigned)e[7] << 16);
                *(u32x4*)(Bt + (size_t)(n0 + nn) * K + k0 + kc) = w;
            }
            __syncthreads();
        }
    }
}

__device__ void transpose_tile(const float* src, size_t sks, bf16_t* dst, size_t dds, LAS unsigned char* lds) {
    LAS bf16_t* tile = (LAS bf16_t*)lds;
    const int tid = otid();
    {
        const int key = tid >> 3, dc = (tid & 7) << 3;
        const float* s = src + (size_t)key * sks + dc;
        const f32x4 a = *(const f32x4*)s, b = *(const f32x4*)(s + 4);
        u32x4 w; w.x = pk_bf16(a[0], a[1]); w.y = pk_bf16(a[2], a[3]); w.z = pk_bf16(b[0], b[1]); w.w = pk_bf16(b[2], b[3]);
        *(LAS u32x4*)(tile + key * 72 + dc) = w;
    }
    __syncthreads();
    {
        const int d = tid >> 3, kc = (tid & 7) << 3;
        unsigned short e[8];
#pragma unroll
        for (int i = 0; i < 8; ++i) e[i] = tile[(kc + i) * 72 + d];
        u32x4 w; w.x = e[0] | ((unsigned)e[1] << 16); w.y = e[2] | ((unsigned)e[3] << 16); w.z = e[4] | ((unsigned)e[5] << 16); w.w = e[6] | ((unsigned)e[7] << 16);
        *(u32x4*)(dst + (size_t)d * dds + kc) = w;
    }
    __syncthreads();
}

__device__ void prep_rows(const Params& P) {
    const int lane = otid() & 63, gw = blockIdx.x * 8 + (otid() >> 6), nw = gridDim.x * 8;
    for (int r = gw; r < MT + 4096; r += nw) {
        const float* src; bf16_t* dst; float* rs;
        if (r < MPR) { src = P.in[0] + (size_t)r * 1024; dst = wsb(P, OFF_H) + (size_t)r * 1024; rs = wsf(P, OFF_RS) + (size_t)r * 16; }
        else if (r < MT) { src = P.in[1] + (size_t)(r - MPR) * 1024; dst = wsb(P, OFF_H) + (size_t)r * 1024; rs = wsf(P, OFF_RS) + (size_t)r * 16; }
        else { const int rm = r - MT; src = P.in[2] + (size_t)rm * 1024; dst = wsb(P, OFF_MEMB) + (size_t)rm * 1024; rs = wsf(P, OFF_RSMEM) + (size_t)rm * 16; }
        float ss = 0.f;
#pragma unroll
        for (int i = 0; i < 4; ++i) {
            const f32x4 v = *(const f32x4*)(src + i * 256 + lane * 4);
            u32x2 w; w.x = pk_bf16(v[0], v[1]); w.y = pk_bf16(v[2], v[3]);
            *(u32x2*)(dst + i * 256 + lane * 4) = w;
            const float a = bf_lo(w.x), b = bf_hi(w.x), c = bf_lo(w.y), d = bf_hi(w.y);
            ss += a * a + b * b + c * c + d * d;
        }
#pragma unroll
        for (int o = 32; o >= 1; o >>= 1) ss += lanex(ss, lane ^ o);
        if (lane < 16) rs[lane] = lane == 0 ? ss : 0.0f;
    }
}

__device__ void prep_misc(const Params& P, LAS unsigned char* lds) {
    const int tid = otid();
    if (blockIdx.x == 0) {
        for (int i = tid; i < 1536; i += 512) {
            float v = 1.0f;
            if (i >= 768) { const float l0 = P.in[12][i - 768], l1 = P.in[12][i]; v = 1.0f / (1.0f + __expf(l1 - l0)); }
            wsf(P, OFF_OML)[i] = v;
        }
        if (tid < 64) ((unsigned*)(P.ws + OFF_CTR))[tid] = 0u;
        for (int i = tid; i < 4096; i += 512) ((unsigned*)(P.ws + OFF_XBAR))[i] = 0u;
    }
    {
        const size_t n4 = (size_t)4 * 16 * 256 * 256 / 4;
        const f32x4* s = (const f32x4*)P.in[8]; u32x2* d = (u32x2*)wsb(P, OFF_MEMK_S);
        for (size_t i = (size_t)blockIdx.x * 512 + tid; i < n4; i += (size_t)gridDim.x * 512) { const f32x4 v = s[i]; u32x2 w; w.x = pk_bf16(v[0], v[1]); w.y = pk_bf16(v[2], v[3]); d[i] = w; }
    }
    for (int t = blockIdx.x; t < 4 * 16 * 4 * 4; t += gridDim.x) {
        const int kt = t & 3, hh = (t >> 2) & 3, lb = t >> 4;
        transpose_tile(P.in[9] + (((size_t)lb * 256 + kt * 64) * 4 + hh) * 64, 256, wsb(P, OFF_MEMVT_S) + (((size_t)lb * 4 + hh) * 64) * 256 + kt * 64, 256, lds);
    }
}

namespace pg8 {
constexpr int BM = 256, BK = 64, HALF = 128, HTB = HALF * BK * 2, STAGE_BYTES = 8 * HTB, NXCD = 8, WGM = 8;
__device__ __forceinline__ int lds_byte(int r, int c) { const int st = (r >> 4) * 2 + (c >> 5), rr = r & 15, cc = c & 31, ob = rr * 64 + cc * 2; return st * 1024 + (ob ^ (((ob >> 9) & 1) << 5)); }
__device__ __forceinline__ void stage_rc(int b, int& R, int& C) { const int st = b / 1024, sb = b % 1024, swz = sb ^ (((sb >> 9) & 1) << 5); R = (st >> 1) * 16 + swz / 64; C = (st & 1) * 32 + (swz % 64) / 2; }
__device__ __forceinline__ int perm32(int rho) { const int n = rho >> 4, i = rho & 15; return 8 * (i >> 2) + 4 * n + (i & 3); }
struct Unit { int pm, pn; };
struct Gemm { const bf16_t* A; const bf16_t* Bt; int M, N, K; };
struct Order {
    int nM, nN, nwg, G, c;
    __device__ void init(int M, int N, int G_, int c_) { nM = M / BM; nN = N / BM; nwg = nM * nN; G = G_; c = c_; }
    __device__ bool next(int i, Unit& u) const {
        const long L = (long)i * G + c; if (L >= nwg) return false;
        int wgid = (int)L; { const int q = nwg / NXCD, r = nwg % NXCD, xcd = wgid % NXCD, off = wgid / NXCD; wgid = (xcd < r ? xcd * (q + 1) : r * (q + 1) + (xcd - r) * q) + off; }
        const int nig = WGM * nN, gid = wgid / nig, fm = gid * WGM, gsz = (nM - fm) < WGM ? (nM - fm) : WGM;
        u.pm = fm + ((wgid % nig) % gsz); u.pn = (wgid % nig) / gsz; return true;
    }
};

template <class Epi>
__device__ __forceinline__ void gemm_phase(LAS unsigned char* lds, const Gemm g, const Order& S, const Epi& E) {
    const int tid = otid(), wid = __builtin_amdgcn_readfirstlane(tid >> 6), lane = tid & 63, wr = wid >> 2, wc = wid & 3, fr = lane & 15, fq = lane >> 4;
    const int K = g.K, nt = K / BK;
    unsigned voffA[2], voffB[2];
#pragma unroll
    for (int i = 0; i < 2; ++i) { int R, C; stage_rc(tid * 16 + i * 8192, R, C); const int Rb = (R & ~31) + perm32(R & 31);
        voffA[i] = (unsigned)(R * K + C) * 2u; voffB[i] = (unsigned)(Rb * K + C) * 2u; }
    const size_t kstep = (size_t)(BK * 2);
    const size_t hstep = (size_t)HALF * K * 2;
    const size_t tstep = 2 * hstep;
    const unsigned ldsw = (unsigned)wid * 1024u;
    const int aoff = lds_byte(wr * 64 + fr, fq * 8), boff = lds_byte(wc * 32 + fr, fq * 8);
#define PG8_SA(b, h) (((b) * 2 + (h)) * HTB)
#define PG8_SB(b, h) ((4 + (b) * 2 + (h)) * HTB)
#define PG8_STAGE(bufoff, gbase, voff) do { _Pragma("unroll") for (int _i = 0; _i < 2; ++_i) \
        __builtin_amdgcn_global_load_lds((const unsigned*)((const char*)(gbase) + (voff)[_i]), (LAS unsigned*)(lds + (bufoff) + ldsw + _i * 8192), 16, 0, 0); } while (0)
#define PG8_LDA(dst, b, h) do { _Pragma("unroll") for (int m = 0; m < 4; ++m) _Pragma("unroll") for (int k = 0; k < 2; ++k) dst[m][k] = *(const LAS bf16x8*)(lds + PG8_SA(b, h) + aoff + m * 2048 + k * 1024); } while (0)
#define PG8_LDB(dst, b, h) do { _Pragma("unroll") for (int n = 0; n < 2; ++n) _Pragma("unroll") for (int k = 0; k < 2; ++k) dst[n][k] = *(const LAS bf16x8*)(lds + PG8_SB(b, h) + boff + n * 2048 + k * 1024); } while (0)
#define PG8_MMA(ai, bj, At, Bt) do { __builtin_amdgcn_s_setprio(1); _Pragma("unroll") for (int m = 0; m < 4; ++m) _Pragma("unroll") for (int n = 0; n < 2; ++n) _Pragma("unroll") for (int k = 0; k < 2; ++k) \
        acc[ai][bj][m][n] = __builtin_amdgcn_mfma_f32_16x16x32_bf16(Bt[n][k], At[m][k], acc[ai][bj][m][n], 0, 0, 0); __builtin_amdgcn_s_setprio(0); } while (0)
#define PG8_WAIT_V(n) asm volatile("s_waitcnt vmcnt(" #n ")" ::: "memory")
#define PG8_WAIT_L(n) asm volatile("s_waitcnt lgkmcnt(" #n ")" ::: "memory")
#define PG8_BAR __builtin_amdgcn_s_barrier()
#define PG8_SCHED __builtin_amdgcn_sched_barrier(0)
    Unit cur, nxt; int ui = 0; int lastpm = -1;
    if (!S.next(0, cur)) return;
    f32x4 acc[2][2][4][2];
#pragma unroll
    for (int a = 0; a < 2; ++a)
#pragma unroll
        for (int b = 0; b < 2; ++b)
#pragma unroll
            for (int m = 0; m < 4; ++m)
#pragma unroll
                for (int n = 0; n < 2; ++n) acc[a][b][m][n] = (f32x4){0.f, 0.f, 0.f, 0.f};
    bf16x8 At[4][2], B0[2][2], B1[2][2];
    const char* cA = (const char*)g.A + (size_t)cur.pm * tstep; const char* cB = (const char*)g.Bt + (size_t)cur.pn * tstep;
    PG8_STAGE(PG8_SB(0, 0), cB, voffB); PG8_STAGE(PG8_SA(0, 0), cA, voffA); PG8_STAGE(PG8_SB(0, 1), cB + hstep, voffB); PG8_STAGE(PG8_SA(0, 1), cA + hstep, voffA);
    if (wr == 1) PG8_BAR;
    PG8_WAIT_V(4); PG8_BAR;
    PG8_STAGE(PG8_SB(1, 0), cB + kstep, voffB); PG8_STAGE(PG8_SA(1, 0), cA + kstep, voffA); PG8_STAGE(PG8_SB(1, 1), cB + hstep + kstep, voffB);
    PG8_WAIT_V(6); PG8_BAR;
    for (;;) {
        const bool has_next = S.next(ui + 1, nxt);
        const char* nA = has_next ? (const char*)g.A + (size_t)nxt.pm * tstep : cA; const char* nB = has_next ? (const char*)g.Bt + (size_t)nxt.pn * tstep : cB;
        for (int t = 0; t < nt; t += 2) {
            const bool last = (t == nt - 2);
            const char* a1 = cA + (size_t)(t + 1) * kstep;
            const char* a2 = last ? nA : cA + (size_t)(t + 2) * kstep; const char* b2 = last ? nB : cB + (size_t)(t + 2) * kstep;
            const char* a3 = a2 + kstep; const char* b3 = b2 + kstep;
            PG8_LDB(B0, 0, 0); PG8_SCHED; PG8_LDA(At, 0, 0); PG8_STAGE(PG8_SA(1, 1), a1 + hstep, voffA);
            PG8_WAIT_L(8); PG8_BAR; PG8_WAIT_L(0); PG8_MMA(0, 0, At, B0); PG8_BAR; PG8_SCHED;
            PG8_LDB(B1, 0, 1); PG8_STAGE(PG8_SB(0, 0), b2, voffB);
            PG8_BAR; PG8_WAIT_L(0); PG8_MMA(0, 1, At, B1); PG8_BAR;
            PG8_LDA(At, 0, 1); PG8_STAGE(PG8_SA(0, 0), a2, voffA);
            PG8_BAR; PG8_WAIT_L(0); PG8_MMA(1, 0, At, B0); PG8_BAR; PG8_SCHED;
            PG8_STAGE(PG8_SB(0, 1), b2 + hstep, voffB);
            PG8_WAIT_V(6); PG8_BAR; PG8_MMA(1, 1, At, B1); PG8_BAR;
            PG8_LDB(B0, 1, 0); PG8_SCHED; PG8_LDA(At, 1, 0); PG8_STAGE(PG8_SA(0, 1), a2 + hstep, voffA);
            PG8_WAIT_L(8); PG8_BAR; PG8_WAIT_L(0); PG8_MMA(0, 0, At, B0); PG8_BAR; PG8_SCHED;
            PG8_LDB(B1, 1, 1); PG8_STAGE(PG8_SB(1, 0), b3, voffB);
            PG8_BAR; PG8_WAIT_L(0); PG8_MMA(0, 1, At, B1); PG8_BAR;
            PG8_LDA(At, 1, 1); PG8_STAGE(PG8_SA(1, 0), a3, voffA);
            PG8_BAR; PG8_WAIT_L(0); PG8_MMA(1, 0, At, B0); PG8_BAR; PG8_SCHED;
            PG8_STAGE(PG8_SB(1, 1), b3 + hstep, voffB);
            PG8_WAIT_V(6); PG8_BAR; PG8_MMA(1, 1, At, B1); PG8_BAR;
        }
        E(acc, cur, wr, wc, fr, fq, lastpm);
        if (!has_next) break;
#pragma unroll
        for (int a = 0; a < 2; ++a)
#pragma unroll
            for (int b = 0; b < 2; ++b)
#pragma unroll
                for (int m = 0; m < 4; ++m)
#pragma unroll
                    for (int n = 0; n < 2; ++n) acc[a][b][m][n] = (f32x4){0.f, 0.f, 0.f, 0.f};
        cur = nxt; cA = nA; cB = nB; ++ui;
    }
    PG8_WAIT_V(0);
    if (wr == 0) PG8_BAR;
    PG8_BAR;
#undef PG8_SA
#undef PG8_SB
#undef PG8_STAGE
#undef PG8_LDA
#undef PG8_LDB
#undef PG8_MMA
#undef PG8_WAIT_V
#undef PG8_WAIT_L
#undef PG8_BAR
#undef PG8_SCHED
}
}

enum { M_INA = 0, M_INB = 1, M_OUT = 2, M_UP = 3, M_KV = 4, M_MEMKV = 5, M_FINAL = 6 };

__device__ __forceinline__ float rowscale(const float* rs) {
    const f32x4 a = *(const f32x4*)rs, b = *(const f32x4*)(rs + 4), c = *(const f32x4*)(rs + 8), d = *(const f32x4*)(rs + 12);
    const float s = (a[0] + a[1] + a[2] + a[3]) + (b[0] + b[1] + b[2] + b[3]) + (c[0] + c[1] + c[2] + c[3]) + (d[0] + d[1] + d[2] + d[3]);
    return __builtin_amdgcn_rsqf(s * (1.0f / 1024.0f) + EPS);
}
__device__ __forceinline__ void headnorm(const f32x4 (&v)[2][2], const float* gain, int fq, int lane, float mul, float (&o)[2][8]) {
    float ss = 0.f;
#pragma unroll
    for (int bj = 0; bj < 2; ++bj)
#pragma unroll
        for (int n = 0; n < 2; ++n)
#pragma unroll
            for (int j = 0; j < 4; ++j) ss += v[bj][n][j] * v[bj][n][j];
    ss += xor16(ss); ss += xor32(ss);
    const float rinv = __builtin_amdgcn_rsqf(ss * (1.0f / 64.0f) + EPS) * mul;
#pragma unroll
    for (int bj = 0; bj < 2; ++bj) {
        const f32x4 g0 = *(const f32x4*)(gain + 32 * bj + 8 * fq), g1 = *(const f32x4*)(gain + 32 * bj + 8 * fq + 4);
#pragma unroll
        for (int j = 0; j < 4; ++j) { o[bj][j] = v[bj][0][j] * rinv * g0[j]; o[bj][4 + j] = v[bj][1][j] * rinv * g1[j]; }
    }
}
__device__ __forceinline__ u32x4 pack8(const float (&x)[8]) { u32x4 w; w.x = pk_bf16(x[0], x[1]); w.y = pk_bf16(x[2], x[3]); w.z = pk_bf16(x[4], x[5]); w.w = pk_bf16(x[6], x[7]); return w; }

template <int MODE> struct Epi {
    const Params& P; int layer; LAS unsigned char* lds; int rowbase; static constexpr int mode = MODE;
    __device__ __forceinline__ void row(int r, int pn, int wc, int fq, int lane, f32x4 (&v)[2][2]) const {
        switch (mode) {
        case M_INA: {
            const int seg = pn / 3;
            if (seg < 4) {
#pragma unroll
                for (int bj = 0; bj < 2; ++bj) {
                    const int cs = (pn - seg * 3) * 256 + bj * 128 + wc * 32 + fq * 8; const size_t o = (size_t)r * 768 + cs;
                    float x[8];
#pragma unroll
                    for (int j = 0; j < 4; ++j) { x[j] = v[bj][0][j]; x[4 + j] = v[bj][1][j]; }
                    if (seg == 0 || seg == 3) {
#pragma unroll
                        for (int j = 0; j < 8; ++j) x[j] = silu_f(x[j]);
                        __builtin_nontemporal_store(pack8(x), (u32x4*)((seg == 0 ? outb(P, DO_QB) : wsb(P, OFF_GATEB)) + o));
                    } else if (seg == 2) {
                        __builtin_nontemporal_store(pack8(x), (u32x4*)(wsb(P, OFF_VB) + o));
                    } else {
                        const float* oml = wsf(P, OFF_OML) + layer * 768 + cs;
                        const f32x4 m0 = *(const f32x4*)oml, m1 = *(const f32x4*)(oml + 4);
                        f32x4 g0, g1;
#pragma unroll
                        for (int j = 0; j < 4; ++j) {
                            const float k0 = fminf(m0[j] * __builtin_amdgcn_rcpf(1.0f + __expf(x[j])), KMAX), k1 = fminf(m1[j] * __builtin_amdgcn_rcpf(1.0f + __expf(x[4 + j])), KMAX);
                            g0[j] = __logf(1.0f - k0); g1[j] = __logf(1.0f - k1);
                        }
                        float* gp = wsf(P, OFF_GB) + o; __builtin_nontemporal_store(g0, (f32x4*)gp); __builtin_nontemporal_store(g1, (f32x4*)(gp + 4));
                    }
                }
            } else {
                float o[2][8]; headnorm(v, P.in[22] + layer * 64, fq, lane, QSCALE, o);
#pragma unroll
                for (int bj = 0; bj < 2; ++bj) __builtin_nontemporal_store(pack8(o[bj]), (u32x4*)(wsb(P, OFF_PMQ) + (size_t)r * 256 + wc * 64 + bj * 32 + fq * 8));
            }
        } break;
        case M_INB: {
            float o[2][8];
            if (pn < 3) { headnorm(v, P.in[15] + (layer - 2) * 64, fq, lane, QSCALE, o);
#pragma unroll
                for (int bj = 0; bj < 2; ++bj) __builtin_nontemporal_store(pack8(o[bj]), (u32x4*)(outb(P, DO_QB) + (size_t)r * 768 + pn * 256 + wc * 64 + bj * 32 + fq * 8));
            } else { headnorm(v, P.in[22] + layer * 64, fq, lane, QSCALE, o);
#pragma unroll
                for (int bj = 0; bj < 2; ++bj) __builtin_nontemporal_store(pack8(o[bj]), (u32x4*)(wsb(P, OFF_PMQ) + (size_t)r * 256 + wc * 64 + bj * 32 + fq * 8));
            }
        } break;
        case M_OUT: case M_FINAL: {
            float ss = 0.f;
#pragma unroll
            for (int bj = 0; bj < 2; ++bj) {
                const int col = pn * 256 + bj * 128 + wc * 32 + fq * 8;
                bf16_t* hp = wsb(P, OFF_H) + (size_t)r * 1024 + col;
                const u32x4 hv = *(const u32x4*)hp;
                float x[8];
                x[0] = bf_lo(hv.x) + v[bj][0][0]; x[1] = bf_hi(hv.x) + v[bj][0][1]; x[2] = bf_lo(hv.y) + v[bj][0][2]; x[3] = bf_hi(hv.y) + v[bj][0][3];
                x[4] = bf_lo(hv.z) + v[bj][1][0]; x[5] = bf_hi(hv.z) + v[bj][1][1]; x[6] = bf_lo(hv.w) + v[bj][1][2]; x[7] = bf_hi(hv.w) + v[bj][1][3];
                if (mode == M_FINAL) {
                    float* yp = (r < MPR) ? P.out + O_YP + (size_t)r * 1024 + col : P.out + O_YS + (size_t)(r - MPR) * 1024 + col;
                    __builtin_nontemporal_store((f32x4){x[0], x[1], x[2], x[3]}, (f32x4*)yp); __builtin_nontemporal_store((f32x4){x[4], x[5], x[6], x[7]}, (f32x4*)(yp + 4));
                } else {
                    const u32x4 w = pack8(x); *(u32x4*)hp = w;
                    const float a0 = bf_lo(w.x), a1 = bf_hi(w.x), a2 = bf_lo(w.y), a3 = bf_hi(w.y), a4 = bf_lo(w.z), a5 = bf_hi(w.z), a6 = bf_lo(w.w), a7 = bf_hi(w.w);
                    ss += a0 * a0 + a1 * a1 + a2 * a2 + a3 * a3 + a4 * a4 + a5 * a5 + a6 * a6 + a7 * a7;
                }
            }
            if (mode == M_OUT) { ss += xor16(ss); ss += xor32(ss); if (fq == 0) wsf(P, OFF_RS)[(size_t)r * 16 + pn * 4 + wc] = ss; }
        } break;
        case M_UP: {
            float x[8];
#pragma unroll
            for (int j = 0; j < 4; ++j) { x[j] = silu_f(v[0][0][j]) * v[1][0][j]; x[4 + j] = silu_f(v[0][1][j]) * v[1][1][j]; }
            __builtin_nontemporal_store(pack8(x), (u32x4*)(act_ptr(P, layer) + (size_t)r * 2816 + pn * 128 + wc * 32 + fq * 8));
        } break;
        case M_KV: {
            const bool pr = r < MPR; const int rr = r - MPR;
            const int b = pr ? (r >> 12) : (rr >> 4), t = pr ? (r & 4095) : (rr & 15);
            if (pn < 3) {
                float o[2][8]; headnorm(v, P.in[19], fq, lane, 1.0f, o);
                const int head = pn * 4 + wc;
                float* fo = pr ? P.out + O_PFK + (size_t)r * 768 : P.out + O_SFK + (size_t)rr * 768;
                bf16_t* kb = pr ? wsb(P, OFF_KBUF_P) + (size_t)r * 768 : wsb(P, OFF_KBUF_S) + ((size_t)b * LS + 4096 + t) * 768;
#pragma unroll
                for (int bj = 0; bj < 2; ++bj) { const int c = head * 64 + bj * 32 + fq * 8;
                    __builtin_nontemporal_store((f32x4){o[bj][0], o[bj][1], o[bj][2], o[bj][3]}, (f32x4*)(fo + c)); __builtin_nontemporal_store((f32x4){o[bj][4], o[bj][5], o[bj][6], o[bj][7]}, (f32x4*)(fo + c + 4));
                    *(u32x4*)(kb + c) = pack8(o[bj]); }
            } else if (pn < 6) {
                float* fo = pr ? P.out + O_PFV + (size_t)r * 768 : P.out + O_SFV + (size_t)rr * 768;
#pragma unroll
                for (int bj = 0; bj < 2; ++bj) { const int c = (pn - 3) * 256 + bj * 128 + wc * 32 + fq * 8;
                    __builtin_nontemporal_store(v[bj][0], (f32x4*)(fo + c)); __builtin_nontemporal_store(v[bj][1], (f32x4*)(fo + c + 4));
                    const int head = c >> 6, d0 = c & 63;
                    bf16_t* vt = pr ? wsb(P, OFF_VT_P) + (((size_t)b * 12 + head) * 64 + d0) * 4096 + t : wsb(P, OFF_VT_S) + (((size_t)b * 12 + head) * 64 + d0) * LS + 4096 + t;
                    const size_t ds = pr ? 4096 : LS;
                    const u32x2 w0 = {pk_bf16(v[bj][0][0], v[bj][0][1]), pk_bf16(v[bj][0][2], v[bj][0][3])}, w1 = {pk_bf16(v[bj][1][0], v[bj][1][1]), pk_bf16(v[bj][1][2], v[bj][1][3])};
                    vt[0] = (bf16_t)(w0.x & 0xffff); vt[ds] = (bf16_t)(w0.x >> 16); vt[2 * ds] = (bf16_t)(w0.y & 0xffff); vt[3 * ds] = (bf16_t)(w0.y >> 16);
                    vt[4 * ds] = (bf16_t)(w1.x & 0xffff); vt[5 * ds] = (bf16_t)(w1.x >> 16); vt[6 * ds] = (bf16_t)(w1.y & 0xffff); vt[7 * ds] = (bf16_t)(w1.y >> 16); }
            } else if (wc == 0) {
                float* lo = pr ? P.out + O_PFL + (size_t)r * 12 : P.out + O_SFL + (size_t)rr * 12;
#pragma unroll
                for (int n = 0; n < 2; ++n)
#pragma unroll
                    for (int j = 0; j < 4; ++j) { const int c = fq * 8 + n * 4 + j;
                        if (c < 12) { const float x = v[0][n][j] + P.in[18][c]; lo[c] = fminf(x, 0.0f) - __logf(1.0f + __expf(-fabsf(x))); } }
            }
        } break;
        case M_MEMKV: {
            const int l = pn >> 1, b = r >> 8, m = r & 255;
            if ((pn & 1) == 0) {
                float o[2][8]; headnorm(v, P.in[23] + l * 64, fq, lane, 1.0f, o);
                const size_t base = ((size_t)l * 4096 + r) * 256;
#pragma unroll
                for (int bj = 0; bj < 2; ++bj) { const int c = wc * 64 + bj * 32 + fq * 8; float* fo = P.out + O_PMK + base + c;
                    *(f32x4*)fo = (f32x4){o[bj][0], o[bj][1], o[bj][2], o[bj][3]}; *(f32x4*)(fo + 4) = (f32x4){o[bj][4], o[bj][5], o[bj][6], o[bj][7]};
                    *(u32x4*)(wsb(P, OFF_MEMK_P) + base + c) = pack8(o[bj]); }
            } else {
                const size_t base = ((size_t)l * 4096 + r) * 256;
#pragma unroll
                for (int bj = 0; bj < 2; ++bj) { const int c = bj * 128 + wc * 32 + fq * 8; float* fo = P.out + O_PMV + base + c;
                    *(f32x4*)fo = v[bj][0]; *(f32x4*)(fo + 4) = v[bj][1];
                    const int head = c >> 6, d0 = c & 63;
                    bf16_t* vt = wsb(P, OFF_MEMVT_P) + ((((size_t)l * 16 + b) * 4 + head) * 64 + d0) * 256 + m;
                    const u32x2 w0 = {pk_bf16(v[bj][0][0], v[bj][0][1]), pk_bf16(v[bj][0][2], v[bj][0][3])}, w1 = {pk_bf16(v[bj][1][0], v[bj][1][1]), pk_bf16(v[bj][1][2], v[bj][1][3])};
                    vt[0] = (bf16_t)(w0.x & 0xffff); vt[256] = (bf16_t)(w0.x >> 16); vt[512] = (bf16_t)(w0.y & 0xffff); vt[768] = (bf16_t)(w0.y >> 16);
                    vt[1024] = (bf16_t)(w1.x & 0xffff); vt[1280] = (bf16_t)(w1.x >> 16); vt[1536] = (bf16_t)(w1.y & 0xffff); vt[1792] = (bf16_t)(w1.y >> 16); }
            }
        } break;
        }
    }
    __device__ __forceinline__ void operator()(const f32x4 (&acc)[2][2][4][2], const pg8::Unit& u, int wr, int wc, int fr_, int fq_, int& lastpm) const {
        int fr = fr_, fq = fq_; asm volatile("" : "+v"(fr), "+v"(fq));
        const float* rsb = (mode == M_MEMKV) ? wsf(P, OFF_RSMEM) : wsf(P, OFF_RS);
        constexpr bool scaled = !(MODE == M_OUT || MODE == M_FINAL);
        const int lane = fq * 16 + fr;
        float scv[8];
        if (scaled) {
            LAS float* sl = (LAS float*)(lds + 131072) + (wr * 4 + wc) * 128;
            if (u.pm != lastpm) {
                lastpm = u.pm;
#pragma unroll
                for (int h = 0; h < 2; ++h) {
                    const int idx = h * 64 + lane;
                    const int r = rowbase + u.pm * 256 + (idx >> 6) * 128 + wr * 64 + (idx & 63);
                    sl[idx] = rowscale(rsb + (size_t)r * 16);
                }
                __builtin_amdgcn_s_waitcnt(0xc07f);
            }
#pragma unroll
            for (int ai = 0; ai < 2; ++ai)
#pragma unroll
                for (int m = 0; m < 4; ++m) scv[ai * 4 + m] = sl[ai * 64 + m * 16 + fr];
        }
#pragma unroll
        for (int ai = 0; ai < 2; ++ai)
#pragma unroll
            for (int m = 0; m < 4; ++m) {
                const int r = rowbase + u.pm * 256 + ai * 128 + wr * 64 + m * 16 + fr;
                const float sc = scaled ? scv[ai * 4 + m] : 1.0f;
                f32x4 v[2][2];
#pragma unroll
                for (int bj = 0; bj < 2; ++bj)
#pragma unroll
                    for (int n = 0; n < 2; ++n) v[bj][n] = acc[ai][bj][m][n] * sc;
                row(r, u.pn, wc, fq, lane, v);
            }
    }
};

__device__ __forceinline__ void run_gemm(const Params& P, LAS unsigned char* lds, const bf16_t* A, const bf16_t* Bt, int M, int N, int K, int mode, int layer, int G, int c, int rowbase) {
    pg8::Gemm g; g.A = A; g.Bt = Bt; g.M = M; g.N = N; g.K = K;
    pg8::Order S; S.init(M, N, G, c);
    switch (mode) {
        case M_INA: { Epi<M_INA> E{P, layer, lds, rowbase}; pg8::gemm_phase(lds, g, S, E); } break;
        case M_INB: { Epi<M_INB> E{P, layer, lds, rowbase}; pg8::gemm_phase(lds, g, S, E); } break;
        case M_OUT: { Epi<M_OUT> E{P, layer, lds, rowbase}; pg8::gemm_phase(lds, g, S, E); } break;
        case M_UP: { Epi<M_UP> E{P, layer, lds, rowbase}; pg8::gemm_phase(lds, g, S, E); } break;
        case M_KV: { Epi<M_KV> E{P, layer, lds, rowbase}; pg8::gemm_phase(lds, g, S, E); } break;
        case M_MEMKV: { Epi<M_MEMKV> E{P, layer, lds, rowbase}; pg8::gemm_phase(lds, g, S, E); } break;
        default: { Epi<M_FINAL> E{P, layer, lds, rowbase}; pg8::gemm_phase(lds, g, S, E); } break;
    }
}

#define MFMA32(a, b, c) __builtin_amdgcn_mfma_f32_32x32x16_bf16((a), (b), (c), 0, 0, 0)

template <int NQB, bool FOX>
__device__ __forceinline__ void attn_wave(const bf16_t* __restrict__ Q, int ldq, int qpos0, const bf16_t* __restrict__ K, int ldk,
                                          const bf16_t* __restrict__ VT, int ldv, const float* __restrict__ cb, int tile_beg, int tile_end,
                                          f32x16 (&O)[NQB][2], float (&mrow)[NQB], float (&lrow)[NQB]) {
    const int lane = otid() & 63, r = lane & 31, hh = lane >> 5;
    bf16x8 qf[NQB][4];
#pragma unroll
    for (int qb = 0; qb < NQB; ++qb)
#pragma unroll
        for (int ks = 0; ks < 4; ++ks) qf[qb][ks] = *(const bf16x8*)(Q + (size_t)(qb * 32 + r) * ldq + ks * 16 + hh * 8);
#pragma unroll
    for (int qb = 0; qb < NQB; ++qb) { mrow[qb] = -1e30f; lrow[qb] = 0.f;
#pragma unroll
        for (int db = 0; db < 2; ++db)
#pragma unroll
            for (int i = 0; i < 16; ++i) O[qb][db][i] = 0.f; }
    if (tile_beg >= tile_end) return;
    bf16x8 kf[4]; u32x2 vlo[2][2], vhi[2][2]; f32x4 cbv[4];
    const bf16_t* kp = K + (size_t)r * ldk + hh * 8;
    const bf16_t* vp0 = VT + (size_t)r * ldv + 4 * hh;
    const bf16_t* vp1 = VT + (size_t)(32 + r) * ldv + 4 * hh;
#define ATT_LOADK(kt) do { _Pragma("unroll") for (int ks = 0; ks < 4; ++ks) kf[ks] = *(const bf16x8*)(kp + (size_t)(kt) * 32 * ldk + ks * 16); } while (0)
#define ATT_LOADC(kt) do { if (FOX) { _Pragma("unroll") for (int g = 0; g < 4; ++g) cbv[g] = *(const f32x4*)(cb + (kt) * 32 + 8 * g + 4 * hh); } } while (0)
#define ATT_LOADV(kt) do { _Pragma("unroll") for (int s = 0; s < 2; ++s) { \
        vlo[0][s] = *(const u32x2*)(vp0 + (kt) * 32 + 16 * s); vhi[0][s] = *(const u32x2*)(vp0 + (kt) * 32 + 16 * s + 8); \
        vlo[1][s] = *(const u32x2*)(vp1 + (kt) * 32 + 16 * s); vhi[1][s] = *(const u32x2*)(vp1 + (kt) * 32 + 16 * s + 8); } } while (0)
    ATT_LOADK(tile_beg); ATT_LOADC(tile_beg); ATT_LOADV(tile_beg);
    for (int kt = tile_beg; kt < tile_end; ++kt) {
        f32x16 S[NQB];
#pragma unroll
        for (int qb = 0; qb < NQB; ++qb) {
#pragma unroll
            for (int i = 0; i < 16; ++i) S[qb][i] = 0.f;
#pragma unroll
            for (int ks = 0; ks < 4; ++ks) S[qb] = MFMA32(kf[ks], qf[qb][ks], S[qb]);
        }
        const int ktn = (kt + 1 < tile_end) ? kt + 1 : kt;
        ATT_LOADK(ktn);
        bf16x8 pf[NQB][2];
#pragma unroll
        for (int qb = 0; qb < NQB; ++qb) {
            float mx = -1e30f;
            if (FOX) {
                const int qpos = qpos0 + qb * 32 + r;
#pragma unroll
                for (int i = 0; i < 16; ++i) { const int key = kt * 32 + 8 * (i >> 2) + 4 * hh + (i & 3);
                    const float s = S[qb][i] - LOG2E * cbv[i >> 2][i & 3]; S[qb][i] = (key <= qpos) ? s : -1e30f; }
            }
#pragma unroll
            for (int i = 0; i < 16; ++i) mx = fmaxf(mx, S[qb][i]);
            mx = fmaxf(mx, xor32(mx));
            const float mnew = fmaxf(mrow[qb], mx);
            const float alpha = __builtin_amdgcn_exp2f(mrow[qb] - mnew);
            mrow[qb] = mnew;
            float ls = 0.f;
#pragma unroll
            for (int i = 0; i < 16; ++i) { S[qb][i] = __builtin_amdgcn_exp2f(S[qb][i] - mnew); ls += S[qb][i]; }
            lrow[qb] = lrow[qb] * alpha + ls;
#pragma unroll
            for (int db = 0; db < 2; ++db)
#pragma unroll
                for (int i = 0; i < 16; ++i) O[qb][db][i] *= alpha;
#pragma unroll
            for (int s = 0; s < 2; ++s) { u32x4 w; w.x = pk_bf16(S[qb][8 * s], S[qb][8 * s + 1]); w.y = pk_bf16(S[qb][8 * s + 2], S[qb][8 * s + 3]); w.z = pk_bf16(S[qb][8 * s + 4], S[qb][8 * s + 5]); w.w = pk_bf16(S[qb][8 * s + 6], S[qb][8 * s + 7]);
                pf[qb][s] = __builtin_bit_cast(bf16x8, w); }
        }
        ATT_LOADC(ktn);
#pragma unroll
        for (int db = 0; db < 2; ++db)
#pragma unroll
            for (int s = 0; s < 2; ++s) { u32x4 w; w.x = vlo[db][s].x; w.y = vlo[db][s].y; w.z = vhi[db][s].x; w.w = vhi[db][s].y; const bf16x8 vf = __builtin_bit_cast(bf16x8, w);
#pragma unroll
                for (int qb = 0; qb < NQB; ++qb) O[qb][db] = MFMA32(vf, pf[qb][s], O[qb][db]); }
        ATT_LOADV(ktn);
    }
#undef ATT_LOADK
#undef ATT_LOADC
#undef ATT_LOADV
}

template <int NQB>
__device__ __forceinline__ void attn_store(f32x16 (&O)[NQB][2], float (&lrow)[NQB], bf16_t* dst, size_t ld, int nvalid) {
    const int lane = otid() & 63, r = lane & 31, hh = lane >> 5;
#pragma unroll
    for (int qb = 0; qb < NQB; ++qb) {
        const float l = lrow[qb] + xor32(lrow[qb]); const float inv = 1.0f / l;
        if (qb * 32 + r < nvalid) {
#pragma unroll
            for (int db = 0; db < 2; ++db)
#pragma unroll
                for (int g = 0; g < 4; ++g) { u32x2 w; w.x = pk_bf16(O[qb][db][4 * g] * inv, O[qb][db][4 * g + 1] * inv); w.y = pk_bf16(O[qb][db][4 * g + 2] * inv, O[qb][db][4 * g + 3] * inv);
                    *(u32x2*)(dst + (size_t)(qb * 32 + r) * ld + db * 32 + g * 8 + hh * 4) = w; }
        }
    }
}

__device__ void mem_unit(const Params& P, int layer, int u) {
    if (u < 4096) {
        const int head = u & 3, qblk = u >> 2, row0 = qblk * 64, b = row0 >> 12;
        f32x16 O[2][2]; float m[2], l[2];
        attn_wave<2, false>(wsb(P, OFF_PMQ) + (size_t)row0 * 256 + head * 64, 256, 0, wsb(P, OFF_MEMK_P) + ((size_t)(layer * 16 + b) * 256) * 256 + head * 64, 256,
                            wsb(P, OFF_MEMVT_P) + (((size_t)(layer * 16 + b) * 4 + head) * 64) * 256, 256, nullptr, 0, 8, O, m, l);
        attn_store<2>(O, l, outb(P, DO_OMIX) + (size_t)row0 * 1024 + 768 + head * 64, 1024, 64);
    } else {
        const int v = u - 4096, head = v & 3, b = v >> 2, row0 = MPR + b * 16;
        f32x16 O[1][2]; float m[1], l[1];
        attn_wave<1, false>(wsb(P, OFF_PMQ) + (size_t)row0 * 256 + head * 64, 256, 0, wsb(P, OFF_MEMK_S) + ((size_t)(layer * 16 + b) * 256) * 256 + head * 64, 256,
                            wsb(P, OFF_MEMVT_S) + (((size_t)(layer * 16 + b) * 4 + head) * 64) * 256, 256, nullptr, 0, 8, O, m, l);
        attn_store<1>(O, l, outb(P, DO_OMIX) + (size_t)row0 * 1024 + 768 + head * 64, 1024, 16);
    }
}

__device__ void fox_prompt_unit(const Params& P, int u) {
    const int grp = u / 1536, idx = u - grp * 1536, bh = idx >> 3, qb64 = 63 - (grp * 8 + (idx & 7));
    const int b = bh / 12, head = bh - b * 12;
    f32x16 O[2][2]; float m[2], l[2];
    const size_t row0 = (size_t)b * 4096 + qb64 * 64;
    attn_wave<2, true>(outb(P, DO_QB) + row0 * 768 + head * 64, 768, qb64 * 64, wsb(P, OFF_KBUF_P) + (size_t)b * 4096 * 768 + head * 64, 768,
                       wsb(P, OFF_VT_P) + ((size_t)bh * 64) * 4096, 4096, wsf(P, OFF_C_P) + (size_t)bh * 4096, 0, 2 * qb64 + 2, O, m, l);
    attn_store<2>(O, l, outb(P, DO_OMIX) + row0 * 1024 + head * 64, 1024, 64);
}


__device__ void fox_prompt_wg(const Params& P, int u, LAS unsigned char* lds) {
    const int tid = otid(), w = tid >> 6, lane = tid & 63, r = lane & 31, hh = lane >> 5;
    const int Qb = 7 - u / 192, bh = u % 192, b = bh / 12, head = bh - b * 12;
    LAS bf16_t* KB = (LAS bf16_t*)lds;
    LAS bf16_t* VB = (LAS bf16_t*)(lds + 18432);
    LAS float* BB = (LAS float*)(lds + 36864);
    const bf16_t* Kg = wsb(P, OFF_KBUF_P) + (size_t)b * 4096 * 768 + head * 64;
    const bf16_t* Vg = wsb(P, OFF_VT_P) + (size_t)bh * 64 * 4096;
    const float* Cg = wsf(P, OFF_C_P) + (size_t)bh * 4096;
    const size_t row0 = (size_t)b * 4096 + 512 * Qb + 64 * w;
    const bf16_t* Qg = outb(P, DO_QB) + row0 * 768 + head * 64;
    bf16x8 qf[2][4];
#pragma unroll
    for (int qb = 0; qb < 2; ++qb)
#pragma unroll
        for (int ks = 0; ks < 4; ++ks) qf[qb][ks] = *(const bf16x8*)(Qg + (size_t)(qb * 32 + r) * 768 + ks * 16 + hh * 8);
    f32x16 O[2][2]; float mref[2], lrow[2];
#pragma unroll
    for (int qb = 0; qb < 2; ++qb) { mref[qb] = 16.0f - LOG2E * Cg[512 * Qb + 64 * w + 32 * qb + r]; lrow[qb] = 0.f;
#pragma unroll
        for (int db = 0; db < 2; ++db)
#pragma unroll
            for (int i = 0; i < 16; ++i) O[qb][db][i] = 0.f; }
    const int nt = 8 * Qb + 8, mylast = 8 * Qb + w;
    const int skey = tid >> 3, sc = tid & 7, vpos = 16 * (sc >> 1) + 4 * (sc & 1);
    u32x4 kreg, vreg; float breg = 0.f;
#define FX_GLOAD(t) do { kreg = *(const u32x4*)(Kg + (size_t)((t) * 64 + skey) * 768 + sc * 8); vreg = *(const u32x4*)(Vg + (size_t)skey * 4096 + (t) * 64 + sc * 8); \
        if (tid < 64) breg = -LOG2E * Cg[(t) * 64 + tid]; } while (0)
#define FX_LSTORE(buf) do { *(LAS u32x4*)(KB + (buf) * 4608 + skey * 72 + sc * 8) = kreg; \
        *(LAS u32x2*)(VB + (buf) * 4608 + skey * 72 + vpos) = (u32x2){vreg.x, vreg.y}; *(LAS u32x2*)(VB + (buf) * 4608 + skey * 72 + vpos + 8) = (u32x2){vreg.z, vreg.w}; \
        if (tid < 64) BB[(buf) * 64 + tid] = breg; } while (0)
    int t0 = 0, myfirst = 0;
    {
        LAS int* slot = (LAS int*)(lds + 131072 + 2560);
        const float cq0 = Cg[512 * Qb + 64 * w];
        const bool need = (lane < nt) ? (LOG2E * (Cg[64 * lane + 63] - cq0) < 64.0f) : true;
        const unsigned long long m = __builtin_amdgcn_ballot_w64(need);
        myfirst = __builtin_amdgcn_readfirstlane((int)__builtin_ctzll(m));
        if (w == 0 && lane == 0) *slot = myfirst;
        __syncthreads();
        t0 = *slot;
        __syncthreads();
    }
    FX_GLOAD(t0); FX_LSTORE(0);
    __syncthreads();
    for (int t = t0; t < nt; ++t) {
        const int cur = (t - t0) & 1;
        if (t + 1 < nt) FX_GLOAD(t + 1);
        if (t >= myfirst && t <= mylast) {
            f32x16 S[2][2];
#pragma unroll
            for (int kb = 0; kb < 2; ++kb) {
                bf16x8 kf[4];
#pragma unroll
                for (int ks = 0; ks < 4; ++ks) kf[ks] = *(const LAS bf16x8*)(KB + cur * 4608 + (32 * kb + r) * 72 + 16 * ks + 8 * hh);
#pragma unroll
                for (int g = 0; g < 4; ++g) { const f32x4 bv = *(const LAS f32x4*)(BB + cur * 64 + 32 * kb + 8 * g + 4 * hh);
#pragma unroll
                    for (int j = 0; j < 4; ++j) { S[0][kb][4 * g + j] = bv[j]; S[1][kb][4 * g + j] = bv[j]; } }
#pragma unroll
                for (int qb = 0; qb < 2; ++qb) {
#pragma unroll
                    for (int ks = 0; ks < 4; ++ks) S[qb][kb] = MFMA32(kf[ks], qf[qb][ks], S[qb][kb]);
                }
            }
            bf16x8 pf[2][4];
#pragma unroll
            for (int qb = 0; qb < 2; ++qb) {
                if (t == mylast) {
                    const int qrel = 32 * qb + r;
#pragma unroll
                    for (int kb = 0; kb < 2; ++kb)
#pragma unroll
                        for (int i = 0; i < 16; ++i) { const int krel = 32 * kb + 8 * (i >> 2) + 4 * hh + (i & 3); if (krel > qrel) S[qb][kb][i] = -1e30f; }
                }
                float ls = 0.f;
#pragma unroll
                for (int kb = 0; kb < 2; ++kb)
#pragma unroll
                    for (int i = 0; i < 16; ++i) { S[qb][kb][i] = __builtin_amdgcn_exp2f(S[qb][kb][i] - mref[qb]); ls += S[qb][kb][i]; }
                lrow[qb] += ls;
#pragma unroll
                for (int kb = 0; kb < 2; ++kb)
#pragma unroll
                    for (int s = 0; s < 2; ++s) { u32x4 wv; wv.x = pk_bf16(S[qb][kb][8 * s], S[qb][kb][8 * s + 1]); wv.y = pk_bf16(S[qb][kb][8 * s + 2], S[qb][kb][8 * s + 3]);
                        wv.z = pk_bf16(S[qb][kb][8 * s + 4], S[qb][kb][8 * s + 5]); wv.w = pk_bf16(S[qb][kb][8 * s + 6], S[qb][kb][8 * s + 7]); pf[qb][2 * kb + s] = __builtin_bit_cast(bf16x8, wv); }
            }
#pragma unroll
            for (int db = 0; db < 2; ++db)
#pragma unroll
                for (int s4 = 0; s4 < 4; ++s4) {
                    const bf16x8 vf = *(const LAS bf16x8*)(VB + cur * 4608 + (32 * db + r) * 72 + 16 * s4 + 8 * hh);
#pragma unroll
                    for (int qb = 0; qb < 2; ++qb) O[qb][db] = MFMA32(vf, pf[qb][s4], O[qb][db]);
                }
        }
        if (t + 1 < nt) FX_LSTORE(cur ^ 1);
        __syncthreads();
    }
#undef FX_GLOAD
#undef FX_LSTORE
    attn_store<2>(O, lrow, outb(P, DO_OMIX) + row0 * 1024 + head * 64, 1024, 64);
}

__device__ void fox_sample_unit(const Params& P, int bh, LAS unsigned char* lds) {
    const int tid = otid(), w = tid >> 6, lane = tid & 63, r = lane & 31, hh = lane >> 5;
    const int b = bh / 12, head = bh - b * 12;
    const size_t row0 = (size_t)MPR + b * 16;
    f32x16 O[1][2]; float m[1], l[1];
    const int tb = w * 17, te = (tb + 17 < 129) ? tb + 17 : 129;
    attn_wave<1, true>(outb(P, DO_QB) + row0 * 768 + head * 64, 768, 4096, wsb(P, OFF_KBUF_S) + (size_t)b * LS * 768 + head * 64, 768,
                       wsb(P, OFF_VT_S) + ((size_t)bh * 64) * LS, LS, wsf(P, OFF_C_S) + (size_t)bh * LS, tb, te, O, m, l);
    LAS float* OL = (LAS float*)lds; LAS float* ML = (LAS float*)(lds + 65536); LAS float* LL = (LAS float*)(lds + 65536 + 1024);
    const float lt = l[0] + xor32(l[0]);
#pragma unroll
    for (int db = 0; db < 2; ++db)
#pragma unroll
        for (int i = 0; i < 16; ++i) OL[(w * 64 + db * 32 + 8 * (i >> 2) + 4 * hh + (i & 3)) * 32 + r] = O[0][db][i];
    if (hh == 0) { ML[w * 32 + r] = m[0]; LL[w * 32 + r] = lt; }
    __syncthreads();
    {
        const int q = tid & 15, dp = tid >> 4;
        float M = -1e30f;
#pragma unroll
        for (int x = 0; x < 8; ++x) M = fmaxf(M, ML[x * 32 + q]);
        float L = 0.f, o0 = 0.f, o1 = 0.f;
#pragma unroll
        for (int x = 0; x < 8; ++x) { const float wg = __builtin_amdgcn_exp2f(ML[x * 32 + q] - M); L += wg * LL[x * 32 + q];
            o0 += wg * OL[(x * 64 + 2 * dp) * 32 + q]; o1 += wg * OL[(x * 64 + 2 * dp + 1) * 32 + q]; }
        const float inv = 1.0f / L;
        *(unsigned*)(outb(P, DO_OMIX) + (row0 + q) * 1024 + head * 64 + 2 * dp) = pk_bf16(o0 * inv, o1 * inv);
    }
    __syncthreads();
}

constexpr int HG_QT = 0, HG_KT = 17408, HG_KTT = 34816, HG_VTT = 53248, HG_PP = 71680, HG_ST = 80896, HG_TOT = 115712, HG_ERHO = 119808, HG_ELAST = 120320, HG_RED = 120832;

__device__ void hgrn_unit(const Params& P, LAS unsigned char* lds, int layer, int path, int b, int hd) {
    const int tid = otid(), w = tid >> 6, lane = tid & 63, r = lane & 31, hh = lane >> 5;
    const int kp = tid & 63, te = w;
    const int nch = path ? 1 : 64, tvalid = path ? 16 : 64;
    const size_t row0 = path ? (size_t)MPR + b * 16 : (size_t)b * 4096;
    const int col0 = hd * 128;
    const int vb = w & 3, tb = w >> 2, kb0 = 2 * (w >> 2);
    const bf16_t* QBp = outb(P, DO_QB); const bf16_t* VBp = wsb(P, OFF_VB); const bf16_t* GTp = wsb(P, OFF_GATEB); const float* GBp = wsf(P, OFF_GB);
    bf16_t* OM = outb(P, DO_OMIX);
    LAS bf16_t* QT = (LAS bf16_t*)(lds + HG_QT); LAS bf16_t* KT = (LAS bf16_t*)(lds + HG_KT); LAS bf16_t* KTT = (LAS bf16_t*)(lds + HG_KTT);
    LAS bf16_t* VTT = (LAS bf16_t*)(lds + HG_VTT); LAS bf16_t* PP = (LAS bf16_t*)(lds + HG_PP); LAS bf16_t* ST = (LAS bf16_t*)(lds + HG_ST);
    LAS float* TOT = (LAS float*)(lds + HG_TOT); LAS float* ERHO = (LAS float*)(lds + HG_ERHO); LAS float* ELAST = (LAS float*)(lds + HG_ELAST); LAS float* RED = (LAS float*)(lds + HG_RED);

    f32x16 accS[2];
    if (path) {
        const float* st = P.in[layer == 0 ? 3 : 4] + ((size_t)(b * 6 + hd) * 128) * 128;
#pragma unroll
        for (int jb = 0; jb < 2; ++jb)
#pragma unroll
            for (int i = 0; i < 16; ++i) accS[jb][i] = st[(size_t)(32 * (kb0 + jb) + 8 * (i >> 2) + 4 * hh + (i & 3)) * 128 + 32 * vb + r];
    } else {
#pragma unroll
        for (int jb = 0; jb < 2; ++jb)
#pragma unroll
            for (int i = 0; i < 16; ++i) accS[jb][i] = 0.f;
    }
    f32x4 gnv[4];
#pragma unroll
    for (int g = 0; g < 4; ++g) gnv[g] = *(const f32x4*)(P.in[13] + layer * 128 + 32 * vb + 8 * g + 4 * hh);

    f32x2 gq[8]; unsigned qq[8], vv[8]; u32x2 gt[4];
#define HG_LOAD(c) do { _Pragma("unroll") for (int i = 0; i < 8; ++i) { const int t = 8 * te + i; \
        if (t < tvalid) { const size_t o = (row0 + (size_t)(c) * 64 + t) * 768 + col0 + 2 * kp; gq[i] = *(const f32x2*)(GBp + o); qq[i] = *(const unsigned*)(QBp + o); vv[i] = *(const unsigned*)(VBp + o); } \
        else { gq[i] = (f32x2){0.f, 0.f}; qq[i] = 0u; vv[i] = 0u; } } } while (0)
#define HG_LOADG(c) do { const int t = 32 * tb + r; _Pragma("unroll") for (int g = 0; g < 4; ++g) { \
        if (t < tvalid) gt[g] = *(const u32x2*)(GTp + (row0 + (size_t)(c) * 64 + t) * 768 + col0 + 32 * vb + 8 * g + 4 * hh); else gt[g] = (u32x2){0u, 0u}; } } while (0)
    HG_LOAD(0);
    for (int c = 0; c < nch; ++c) {
        f32x2 bl[8];
        { f32x2 run = {0.f, 0.f};
#pragma unroll
          for (int i = 0; i < 8; ++i) { run += gq[i]; bl[i] = run; }
          *(LAS f32x2*)(TOT + te * 128 + 2 * kp) = run; }
        __syncthreads();
        {
            f32x2 pre = {0.f, 0.f}, rho = {0.f, 0.f}, bla = {0.f, 0.f};
#pragma unroll
            for (int e = 0; e < 8; ++e) { const f32x2 tv = *(const LAS f32x2*)(TOT + e * 128 + 2 * kp); if (e < te) pre += tv; if (e < 4) rho += tv; bla += tv; }
            unsigned k0p[4], k1p[4], v0p[4], v1p[4];
            float kt0[8], kt1[8];
#pragma unroll
            for (int i = 0; i < 8; ++i) {
                const int t = 8 * te + i;
                const f32x2 bb = pre + bl[i];
                const float eq0 = __expf(fminf(bb[0] - rho[0], 80.f)), eq1 = __expf(fminf(bb[1] - rho[1], 80.f));
                const float ek0 = __expf(fminf(rho[0] - bb[0], 80.f)), ek1 = __expf(fminf(rho[1] - bb[1], 80.f));
                const float kk0 = 1.0f - __expf(gq[i][0]), kk1 = 1.0f - __expf(gq[i][1]);
                const float q0 = bf_lo(qq[i]) * eq0, q1 = bf_hi(qq[i]) * eq1;
                kt0[i] = kk0 * ek0; kt1[i] = kk1 * ek1;
                *(LAS unsigned*)(QT + t * 136 + 2 * kp) = pk_bf16(q0, q1);
                *(LAS unsigned*)(KT + t * 136 + 2 * kp) = pk_bf16(kt0[i], kt1[i]);
            }
#pragma unroll
            for (int i = 0; i < 4; ++i) { k0p[i] = pk_bf16(kt0[2 * i], kt0[2 * i + 1]); k1p[i] = pk_bf16(kt1[2 * i], kt1[2 * i + 1]);
                v0p[i] = (vv[2 * i] & 0xffffu) | (vv[2 * i + 1] << 16); v1p[i] = (vv[2 * i] >> 16) | (vv[2 * i + 1] & 0xffff0000u); }
            *(LAS u32x4*)(KTT + (2 * kp) * 72 + 8 * te) = (u32x4){k0p[0], k0p[1], k0p[2], k0p[3]};
            *(LAS u32x4*)(KTT + (2 * kp + 1) * 72 + 8 * te) = (u32x4){k1p[0], k1p[1], k1p[2], k1p[3]};
            *(LAS u32x4*)(VTT + (2 * kp) * 72 + 8 * te) = (u32x4){v0p[0], v0p[1], v0p[2], v0p[3]};
            *(LAS u32x4*)(VTT + (2 * kp + 1) * 72 + 8 * te) = (u32x4){v1p[0], v1p[1], v1p[2], v1p[3]};
            if (te == 0) { *(LAS f32x2*)(ERHO + 2 * kp) = (f32x2){__expf(rho[0]), __expf(rho[1])}; *(LAS f32x2*)(ELAST + 2 * kp) = (f32x2){__expf(bla[0] - rho[0]), __expf(bla[1] - rho[1])}; }
        }
        if (c + 1 < nch) HG_LOAD(c + 1);
        HG_LOADG(c);
        __syncthreads();
#pragma unroll
        for (int jb = 0; jb < 2; ++jb)
#pragma unroll
            for (int g = 0; g < 4; ++g) {
                const f32x4 er = *(const LAS f32x4*)(ERHO + 32 * (kb0 + jb) + 8 * g + 4 * hh);
#pragma unroll
                for (int j = 0; j < 4; ++j) accS[jb][4 * g + j] *= er[j];
                *(LAS u32x2*)(ST + (32 * vb + r) * 136 + 32 * (kb0 + jb) + 8 * g + 4 * hh) = (u32x2){pk_bf16(accS[jb][4 * g], accS[jb][4 * g + 1]), pk_bf16(accS[jb][4 * g + 2], accS[jb][4 * g + 3])};
            }
        __syncthreads();
        if (w < 3) {
            const int ptb = w ? 1 : 0, psb = (w == 2) ? 1 : 0;
            f32x16 ap;
#pragma unroll
            for (int i = 0; i < 16; ++i) ap[i] = 0.f;
#pragma unroll
            for (int ks = 0; ks < 8; ++ks) {
                const bf16x8 a = *(const LAS bf16x8*)(KT + (32 * psb + r) * 136 + ks * 16 + 8 * hh);
                const bf16x8 bq = *(const LAS bf16x8*)(QT + (32 * ptb + r) * 136 + ks * 16 + 8 * hh);
                ap = MFMA32(a, bq, ap);
            }
            const int t = 32 * ptb + r;
#pragma unroll
            for (int g = 0; g < 4; ++g) { float x[4];
#pragma unroll
                for (int j = 0; j < 4; ++j) { const int s = 32 * psb + 8 * g + 4 * hh + j; x[j] = (s <= t) ? ap[4 * g + j] : 0.f; }
                *(LAS u32x2*)(PP + t * 72 + 32 * psb + 8 * g + 4 * hh) = (u32x2){pk_bf16(x[0], x[1]), pk_bf16(x[2], x[3])}; }
        }
        f32x16 ao;
#pragma unroll
        for (int i = 0; i < 16; ++i) ao[i] = 0.f;
#pragma unroll
        for (int ks = 0; ks < 8; ++ks) {
            const bf16x8 a = *(const LAS bf16x8*)(ST + (32 * vb + r) * 136 + ks * 16 + 8 * hh);
            const bf16x8 bq = *(const LAS bf16x8*)(QT + (32 * tb + r) * 136 + ks * 16 + 8 * hh);
            ao = MFMA32(a, bq, ao);
        }
#pragma unroll
        for (int ks = 0; ks < 4; ++ks) {
            const bf16x8 bv = *(const LAS bf16x8*)(VTT + (32 * vb + r) * 72 + ks * 16 + 8 * hh);
#pragma unroll
            for (int jb = 0; jb < 2; ++jb) { const bf16x8 a = *(const LAS bf16x8*)(KTT + (32 * (kb0 + jb) + r) * 72 + ks * 16 + 8 * hh); accS[jb] = MFMA32(a, bv, accS[jb]); }
        }
#pragma unroll
        for (int jb = 0; jb < 2; ++jb)
#pragma unroll
            for (int g = 0; g < 4; ++g) { const f32x4 el = *(const LAS f32x4*)(ELAST + 32 * (kb0 + jb) + 8 * g + 4 * hh);
#pragma unroll
                for (int j = 0; j < 4; ++j) accS[jb][4 * g + j] *= el[j]; }
        __syncthreads();
        {
            const int nks = tb ? 4 : 2;
            for (int ks = 0; ks < nks; ++ks) {
                const bf16x8 a = *(const LAS bf16x8*)(VTT + (32 * vb + r) * 72 + ks * 16 + 8 * hh);
                const bf16x8 bp = *(const LAS bf16x8*)(PP + (32 * tb + r) * 72 + ks * 16 + 8 * hh);
                ao = MFMA32(a, bp, ao);
            }
        }
        {
            float ss = 0.f;
#pragma unroll
            for (int i = 0; i < 16; ++i) ss += ao[i] * ao[i];
            ss += xor32(ss);
            if (hh == 0) RED[vb * 64 + 32 * tb + r] = ss;
        }
        __syncthreads();
        {
            const int t = 32 * tb + r;
            const float tot = RED[t] + RED[64 + t] + RED[128 + t] + RED[192 + t];
            const float rinv = __builtin_amdgcn_rsqf(tot * (1.0f / 128.0f) + EPS);
            if (t < tvalid) {
                bf16_t* op = OM + (row0 + (size_t)c * 64 + t) * 1024 + col0 + 32 * vb + 4 * hh;
#pragma unroll
                for (int g = 0; g < 4; ++g) {
                    const float x0 = ao[4 * g] * rinv * gnv[g][0] * bf_lo(gt[g].x), x1 = ao[4 * g + 1] * rinv * gnv[g][1] * bf_hi(gt[g].x);
                    const float x2 = ao[4 * g + 2] * rinv * gnv[g][2] * bf_lo(gt[g].y), x3 = ao[4 * g + 3] * rinv * gnv[g][3] * bf_hi(gt[g].y);
                    *(u32x2*)(op + 8 * g) = (u32x2){pk_bf16(x0, x1), pk_bf16(x2, x3)};
                }
            }
        }
    }
#undef HG_LOAD
#undef HG_LOADG
    {
        float* so = P.out + (path ? (layer == 0 ? O_SST0 : O_SST1) : (layer == 0 ? O_PST0 : O_PST1)) + ((size_t)(b * 6 + hd) * 128) * 128;
#pragma unroll
        for (int jb = 0; jb < 2; ++jb)
#pragma unroll
            for (int i = 0; i < 16; ++i) so[(size_t)(32 * (kb0 + jb) + 8 * (i >> 2) + 4 * hh + (i & 3)) * 128 + 32 * vb + r] = accS[jb][i];
    }
    __syncthreads();
}

__device__ __forceinline__ int grab(unsigned* ctr) {
    int u = 0;
    if ((otid() & 63) == 0) u = (int)atomicAdd(ctr, 1u);
    return __builtin_amdgcn_readfirstlane(u);
}

__device__ void conv_v(const Params& P, LAS unsigned char* lds, int widx, int wcount) {
    for (int t = widx; t < NB * 12 * 64; t += wcount) {
        const int kt = t & 63, bh = t >> 6, b = bh / 12, head = bh - b * 12;
        transpose_tile(P.in[6] + (((size_t)b * 4096 + kt * 64) * 12 + head) * 64, 768, wsb(P, OFF_VT_S) + ((size_t)bh * 64) * LS + kt * 64, LS, lds);
    }
}

__device__ void mix_a(const Params& P, LAS unsigned char* lds, int layer, unsigned* ctr, int mode, int c) {
    const int hbeg = mode ? 96 + c : (int)blockIdx.x, hend = mode ? 192 : 96, hstr = mode ? NG : (int)gridDim.x;
    for (int u = hbeg; u < hend; u += hstr) { const int path = u >= 96, v = path ? u - 96 : u; hgrn_unit(P, lds, layer, path, v / 6, v % 6); }
    if (!mode && layer == 1 && (int)blockIdx.x >= 96) conv_v(P, lds, (int)blockIdx.x - 96, (int)gridDim.x - NG - 96);
    int mnext = 4096 + c * 8 + (otid() >> 6);
    for (;;) {
        int u, lim;
        if (mode) { u = mnext; mnext += NG * 8; lim = 4096 + 64; } else { u = grab(ctr); lim = 4096; }
        if (u >= lim) break;
        mem_unit(P, layer, u);
    }
}

__device__ void mix_b(const Params& P, LAS unsigned char* lds, int layer, unsigned* ctr, int mode, int c) {
    unsigned* fsdone = ctr + 44;
    if (!mode) {
        const bool has = (int)blockIdx.x < 192;
        for (int u = blockIdx.x; u < 192; u += gridDim.x) fox_sample_unit(P, u, lds);
        if (has) {
            asm volatile("s_waitcnt vmcnt(0)" ::: "memory");
            __syncthreads();
            if (threadIdx.x == 0) { __builtin_amdgcn_fence(__ATOMIC_RELEASE, "agent"); asm volatile("s_waitcnt vmcnt(0)" ::: "memory"); (void)xb_add(fsdone, 1u); }
        }
        LAS int* slot = (LAS int*)(lds + 131072 + 2048);
        for (;;) {
            if (otid() == 0) *slot = (int)atomicAdd(ctr + 16 + layer, 1u);
            __syncthreads();
            const int u = *slot;
            __syncthreads();
            if (u >= 1536) break;
            fox_prompt_wg(P, u, lds);
        }
    }
    int mnext = 4096 + c * 8 + (otid() >> 6);
    for (;;) {
        int u, lim;
        if (mode) { u = mnext; mnext += NG * 8; lim = 4096 + 64; } else { u = grab(ctr); lim = 4096; }
        if (u >= lim) break;
        mem_unit(P, layer, u);
    }
    if (mode) {
        if (threadIdx.x == 0) { unsigned sp = 0; while (xb_ld(fsdone) < 192u) { __builtin_amdgcn_s_sleep(2); if (++sp > (1u << 22)) break; } }
    }
}

__device__ void cum_phase(const Params& P, LAS unsigned char* lds, int mode, int c) {
    const int nb = (int)gridDim.x - NG;
    const int tid = otid(), lane = tid & 63, gw = (mode ? c : (int)blockIdx.x) * 8 + (tid >> 6), nw = (mode ? NG : nb) * 8;
    for (int u = mode ? 192 + gw : gw; u < (mode ? 384 : 192); u += nw) {
        const bool smp = u >= 192; const int bh = smp ? u - 192 : u, b = bh / 12, head = bh - b * 12;
        const float* src = smp ? P.in[7] + (size_t)b * 4096 * 12 + head : P.out + O_PFL + (size_t)b * 4096 * 12 + head;
        float* dst = smp ? wsf(P, OFF_C_S) + (size_t)bh * LS : wsf(P, OFF_C_P) + (size_t)bh * 4096;
        float tot = 0.f;
        for (int i = 0; i < 64; ++i) tot += src[(size_t)(lane * 64 + i) * 12];
        float inc = tot;
#pragma unroll
        for (int o = 1; o < 64; o <<= 1) { const float x = lanex(inc, (lane - o) & 63); if (lane >= o) inc += x; }
        float run = inc - tot;
        for (int i = 0; i < 64; ++i) { run += src[(size_t)(lane * 64 + i) * 12]; dst[lane * 64 + i] = run; }
        if (smp) {
            float last = lanex(run, 63);
            if (lane == 0) { for (int t = 0; t < 16; ++t) { last += P.out[O_SFL + (size_t)(b * 16 + t) * 12 + head]; dst[4096 + t] = last; }
                for (int t = 16; t < 32; ++t) dst[4096 + t] = last; }
        }
    }
    if (mode) return;
    {
        const size_t n8 = (size_t)NB * 4096 * 768 / 8;
        for (size_t i = (size_t)blockIdx.x * 512 + tid; i < n8; i += (size_t)nb * 512) {
            const size_t e = i * 8, bt = e / 768, c = e - bt * 768, b = bt >> 12, t = bt & 4095;
            const f32x4 a = *(const f32x4*)(P.in[5] + e), bb = *(const f32x4*)(P.in[5] + e + 4);
            u32x4 w; w.x = pk_bf16(a[0], a[1]); w.y = pk_bf16(a[2], a[3]); w.z = pk_bf16(bb[0], bb[1]); w.w = pk_bf16(bb[2], bb[3]);
            *(u32x4*)(wsb(P, OFF_KBUF_S) + (b * LS + t) * 768 + c) = w;
        }
    }
}

#define XB_TMO      128
#define XB_XCNT(j)  (256  + 64 * (j))
#define XB_XSUB(j)  (1280 + 64 * (j))
#define XB_XGEN(j)  (2304 + 64 * (j))
#define XB_TOP      3328
#define XB_TOPGEN   3392
#define XCD_BAR_WORDS 3456
#define XB_SPIN_CAP (1u << 18)
__device__ __forceinline__ unsigned xb_xcc_id() { return (unsigned)__builtin_amdgcn_s_getreg((3 << 11) | 20) & 0xFu; }
#define XB_SPIN(cond, bar) do { unsigned _sp = 0; while (cond) { __builtin_amdgcn_s_sleep(1); \
    if ((++_sp & 255u) == 0u) { if (xb_ld(&(bar)[XB_TMO])) break; if (_sp > XB_SPIN_CAP) { atomicAdd(&(bar)[XB_TMO], 1u); break; } } } } while (0)
struct XcdBarrier { unsigned* bar; unsigned x; volatile LAS unsigned* st; };
__device__ __forceinline__ XcdBarrier xcd_barrier_post(unsigned* bar, volatile LAS unsigned* st) {
    XcdBarrier b; b.bar = bar; b.x = xb_xcc_id(); b.st = st;
    if (threadIdx.x == 0) (void)xb_add(&bar[XB_XCNT(b.x)], 1u);
    return b;
}
__device__ __forceinline__ void xcd_barrier_complete(unsigned* bar, unsigned x, unsigned& nloc, unsigned& nx) {
    const unsigned G = gridDim.x * gridDim.y * gridDim.z;
    unsigned sum, cnt, mine, sp = 0u;
    for (;;) {
        sum = 0u; cnt = 0u; mine = 0u;
#pragma unroll
        for (unsigned j = 0; j < 16; ++j) { const unsigned c = xb_ld(&bar[XB_XCNT(j)]); sum += c; cnt += (c > 0u) ? 1u : 0u; mine = (j == x) ? c : mine; }
        if (sum == G) break;
        __builtin_amdgcn_s_sleep(1);
        if ((++sp & 255u) == 0u) { if (xb_ld(&bar[XB_TMO])) break; if (sp > XB_SPIN_CAP) { atomicAdd(&bar[XB_TMO], 1u); break; } }
    }
    nloc = mine > 0u ? mine : 1u; nx = cnt > 0u ? cnt : 1u;
}
__device__ __forceinline__ void xcd_barrier(const XcdBarrier& b) {
    asm volatile("s_waitcnt vmcnt(0)" ::: "memory");
    __syncthreads();
    if (threadIdx.x == 0) {
        unsigned* bar = b.bar;
        __builtin_amdgcn_s_waitcnt(0);
        unsigned nloc = b.st[0], nx = b.st[1];
        if (nloc == 0u) { xcd_barrier_complete(bar, b.x, nloc, nx); b.st[0] = nloc; b.st[1] = nx; }
        const unsigned old = xb_add(&bar[XB_XSUB(b.x)], 1u);
        const unsigned gen = old / nloc;
        if (old + 1u == (gen + 1u) * nloc) {
            __builtin_amdgcn_fence(__ATOMIC_RELEASE, "agent");
            asm volatile("s_waitcnt vmcnt(0)" ::: "memory");
            const unsigned og = xb_add(&bar[XB_TOP], 1u);
            const unsigned tg = og / nx;
            if (og + 1u == (tg + 1u) * nx) xb_add(&bar[XB_TOPGEN], 1u);
            else XB_SPIN(xb_ld(&bar[XB_TOPGEN]) == tg, bar);
            __builtin_amdgcn_fence(__ATOMIC_ACQUIRE, "agent");
            xb_add(&bar[XB_XGEN(b.x)], 1u);
            asm volatile("s_waitcnt vmcnt(0)" ::: "memory");
        } else {
            XB_SPIN(xb_ld(&bar[XB_XGEN(b.x)]) == gen, bar);
            __builtin_amdgcn_fence(__ATOMIC_ACQUIRE, "agent");
            asm volatile("s_waitcnt vmcnt(0)" ::: "memory");
        }
    }
    __syncthreads();
}

__device__ __forceinline__ void sub_barrier(unsigned* cnt) {
    asm volatile("s_waitcnt vmcnt(0)" ::: "memory");
    __syncthreads();
    if (threadIdx.x == 0) {
        __builtin_amdgcn_fence(__ATOMIC_RELEASE, "agent"); asm volatile("s_waitcnt vmcnt(0)" ::: "memory");
        const unsigned old = xb_add(cnt, 1u), target = (old / NG + 1u) * NG;
        unsigned sp = 0; while (xb_ld(cnt) < target) { __builtin_amdgcn_s_sleep(1); if (++sp > (1u << 22)) break; }
        __builtin_amdgcn_fence(__ATOMIC_ACQUIRE, "agent"); asm volatile("s_waitcnt vmcnt(0)" ::: "memory");
    }
    __syncthreads();
}
#define EN(kind, who, bar, code, layer) ((kind) | ((who) << 3) | ((bar) << 5) | ((code) << 7) | ((layer) << 10))
constexpr int NEN = 50;
__constant__ unsigned short PROG[NEN] = {
    EN(0, 0, 1, 0, 0), EN(1, 0, 0, 0, 0), EN(1, 0, 1, 1, 0),
    EN(2, 1, 0, 0, 0), EN(1, 2, 2, 0, 0), EN(2, 2, 2, 0, 0), EN(1, 2, 2, 2, 0), EN(1, 2, 2, 3, 0), EN(1, 2, 2, 4, 0), EN(1, 2, 0, 0, 1), EN(2, 3, 1, 0, 0),
    EN(1, 0, 1, 2, 0), EN(1, 0, 1, 3, 0), EN(1, 0, 1, 4, 0), EN(1, 0, 1, 0, 1),
    EN(2, 1, 0, 0, 1), EN(2, 2, 2, 0, 1), EN(1, 2, 2, 2, 1), EN(1, 2, 2, 3, 1), EN(1, 2, 0, 4, 1), EN(2, 3, 1, 0, 1),
    EN(1, 0, 1, 2, 1), EN(1, 0, 1, 3, 1), EN(1, 0, 1, 4, 1), EN(1, 0, 0, 5, 1), EN(1, 0, 1, 6, 2),
    EN(4, 1, 0, 0, 0), EN(1, 2, 0, 5, 1), EN(1, 2, 2, 6, 2), EN(4, 2, 1, 0, 0),
    EN(3, 1, 0, 0, 2), EN(3, 2, 2, 0, 2), EN(1, 2, 2, 2, 2), EN(1, 2, 2, 3, 2), EN(1, 2, 2, 4, 2), EN(1, 2, 0, 6, 3), EN(3, 3, 1, 0, 2),
    EN(1, 0, 1, 2, 2), EN(1, 0, 1, 3, 2), EN(1, 0, 1, 4, 2), EN(1, 0, 1, 6, 3),
    EN(3, 1, 0, 0, 3), EN(3, 2, 2, 0, 3), EN(1, 2, 2, 2, 3), EN(1, 2, 2, 3, 3), EN(1, 2, 0, 4, 3), EN(3, 3, 1, 0, 3),
    EN(1, 0, 1, 2, 3), EN(1, 0, 1, 3, 3), EN(1, 0, 0, 4, 3) };

__global__ void __launch_bounds__(512, 2) yoco_fwd(const Params P) {
    extern __shared__ __attribute__((aligned(16))) unsigned char shm[];
    LAS unsigned char* lds = (LAS unsigned char*)shm;
    cg::grid_group grid = cg::this_grid();
    unsigned* ctr = (unsigned*)(P.ws + OFF_CTR);
    volatile LAS unsigned* xst = (volatile LAS unsigned*)(lds + 131072 + 4096);
    if (threadIdx.x == 0) { xst[0] = 0u; xst[1] = 0u; }
    __syncthreads();
    XcdBarrier xb; xb.bar = (unsigned*)(P.ws + OFF_XBAR); xb.x = 0; xb.st = xst;
    const int bid = blockIdx.x, G = gridDim.x, gc = bid - (G - NG);
    const bool ingroup = gc >= 0;
#pragma nounroll
    for (int e = 0; e < NEN; ++e) {
        const unsigned en = PROG[e]; const int kind = en & 7, who = (en >> 3) & 3, bar = (en >> 5) & 3, code = (en >> 7) & 7, l = (en >> 10) & 3;
        const bool mine = who == 0 || (who == 1 && !ingroup) || (who >= 2 && ingroup);
#ifdef DUP_IN
        const int nrep = (kind == 1 && who == 0 && (code == 0 || code == 5 || code == 6)) ? 2 : 1;
#else
        const int nrep = 1;
#endif
#pragma nounroll
        for (int rep = 0; rep < nrep; ++rep)
        if (mine) {
            const int smp = who == 2;
            if (kind == 0) { prep_weights(P, lds); prep_rows(P); prep_misc(P, lds); }
            else if (kind == 1) {
                const bf16_t* A = wsb(P, OFF_H); const bf16_t* Bt; int M = smp ? 256 : MPR, N = 1024, K = 1024, mode;
                switch (code) {
                    case 0: Bt = wsb(P, OFF_WINA + (size_t)l * SZ_WINA); N = 3328; mode = M_INA; break;
                    case 1: A = wsb(P, OFF_MEMB); Bt = wsb(P, OFF_WMEM); M = 4096; N = 2048; mode = M_MEMKV; break;
                    case 2: A = outb(P, DO_OMIX); Bt = w_out_ptr(P, l); mode = M_OUT; break;
                    case 3: Bt = w_up_ptr(P, l); N = 5632; mode = M_UP; break;
                    case 4: A = act_ptr(P, l); Bt = w_dn_ptr(P, l); K = 2816; mode = (l == 3) ? M_FINAL : M_OUT; break;
                    case 5: Bt = wsb(P, OFF_WKV); N = 1792; mode = M_KV; break;
                    default: Bt = wsb(P, OFF_WINB + (size_t)(l - 2) * SZ_W1K); mode = M_INB; break;
                }
                const int rowbase = smp ? MPR : 0;
                const int cs = (code == 6 && l == 2) ? (gc + NG - 7) % NG : gc;
                run_gemm(P, lds, A + (size_t)rowbase * K, Bt, M, N, K, mode, l, smp ? NG : G, smp ? cs : bid, rowbase);
            }
            else if (kind == 2) mix_a(P, lds, l, ctr + l, smp, gc);
            else if (kind == 3) mix_b(P, lds, l, ctr + l, smp, gc);
            else cum_phase(P, lds, smp, gc);
        }
        if (bar == 1) { if (e == 0) { grid.sync(); xb = xcd_barrier_post((unsigned*)(P.ws + OFF_XBAR), xst); } else xcd_barrier(xb); }
        else if (bar == 2 && ingroup) sub_barrier(ctr + 40);
    }
}

extern "C" void kernel_launch(void* const* d_in, const int* in_sizes, int n_in, void* d_out, int out_size, void* d_ws, size_t ws_size, hipStream_t stream) {
    static int grid = 0;
    if (grid == 0) {
        int dev = 0, cus = 0, per_cu = 0;
        hipGetDevice(&dev);
        hipDeviceGetAttribute(&cus, hipDeviceAttributeMultiprocessorCount, dev);
        hipFuncSetAttribute((const void*)yoco_fwd, hipFuncAttributeMaxDynamicSharedMemorySize, LDS_BYTES);
        hipOccupancyMaxActiveBlocksPerMultiprocessor(&per_cu, (const void*)yoco_fwd, 512, LDS_BYTES);
        if (per_cu < 1) per_cu = 1;
        (void)hipGetLastError();
        grid = cus * 1;
        if (ws_size < WS_END) fprintf(stderr, "kernel_launch: workspace too small (%zu < %zu)\n", ws_size, (size_t)WS_END);
    }
    Params p{};
    for (int i = 0; i < 28; ++i) p.in[i] = (const float*)d_in[i];
    p.out = (float*)d_out; p.ws = (unsigned char*)d_ws;
    unsigned char* ws = (unsigned char*)d_ws;
    int j = 0;
    auto add = [&](const float* W, const float* gain, size_t off, int K, int Ntrue, int Np, int kind) { p.wj[j].W = W; p.wj[j].gain = gain; p.wj[j].Bt = (bf16_t*)(ws + off); p.wj[j].K = K; p.wj[j].Ntrue = Ntrue; p.wj[j].Np = Np; p.wj[j].kind = kind; ++j; };
    for (int l = 0; l < 2; ++l) add(p.in[11] + (size_t)l * 1024 * 3328, p.in[10] + l * 1024, OFF_WINA + l * SZ_WINA, 1024, 3328, 3328, 2);
    for (int l = 0; l < 2; ++l) add(p.in[14] + (size_t)l * 1024 * 1024, p.in[10] + (2 + l) * 1024, OFF_WINB + l * SZ_W1K, 1024, 1024, 1024, 1);
    add(p.in[17], p.in[16], OFF_WKV, 1024, 1548, 1792, 4);
    for (int l = 0; l < 4; ++l) add(p.in[21] + (size_t)l * 1024 * 512, p.in[20] + l * 1024, OFF_WMEM + (size_t)l * 512 * 1024 * 2, 1024, 512, 512, 5);
    for (int l = 0; l < 4; ++l) add(p.in[24] + (size_t)l * 1024 * 1024, nullptr, l < 2 ? OFF_WOUT01 + l * SZ_W1K : OFF_WOUT23 + (l - 2) * SZ_W1K, 1024, 1024, 1024, 0);
    for (int l = 0; l < 4; ++l) add(p.in[26] + (size_t)l * 1024 * 5632, p.in[25] + l * 1024, l < 2 ? OFF_WUP01 + l * SZ_WUP : OFF_WUP23 + (l - 2) * SZ_WUP, 1024, 5632, 5632, 3);
    for (int l = 0; l < 4; ++l) add(p.in[27] + (size_t)l * 2816 * 1024, nullptr, l < 2 ? OFF_WDN01 + l * SZ_WDN : OFF_WDN23 + (l - 2) * SZ_WDN, 2816, 1024, 1024, 0);
    void* args[] = {&p};
    hipError_t e = hipLaunchCooperativeKernel((const void*)yoco_fwd, dim3(grid), dim3(512), args, LDS_BYTES, stream);
    if (e != hipSuccess) fprintf(stderr, "cooperative launch failed: %s (grid %d)\n", hipGetErrorString(e), grid);
}
```

```cpp
#include <hip/hip_runtime.h>
#include <hip/hip_cooperative_groups.h>
#include <cstdio>
namespace cg = cooperative_groups;

#define LAS __attribute__((address_space(3)))
typedef unsigned short bf16_t;
typedef short bf16x8 __attribute__((ext_vector_type(8)));
typedef float f32x4 __attribute__((ext_vector_type(4)));
typedef float f32x2 __attribute__((ext_vector_type(2)));
typedef float f32x16 __attribute__((ext_vector_type(16)));
typedef unsigned u32x4 __attribute__((ext_vector_type(4)));
typedef unsigned u32x2 __attribute__((ext_vector_type(2)));

constexpr int NB = 16, TP = 4096, TS = 16;
constexpr int MPR = NB * TP;
constexpr int MSR = NB * TS;
constexpr int MT = MPR + MSR;
constexpr int MR = MT + 64;
constexpr int LS = 4128;
constexpr float EPS = 1e-6f, KMAX = 0.999999f, LOG2E = 1.4426950408889634f, QSCALE = 0.125f * 1.4426950408889634f;

constexpr size_t O_YP = 0, O_YS = 67108864, O_PST0 = 67371008, O_PST1 = 68943872, O_PFK = 70516736, O_PFV = 120848384,
                 O_PFL = 171180032, O_PMK = 171966464, O_PMV = 176160768, O_SST0 = 180355072, O_SST1 = 181927936,
                 O_SFK = 183500800, O_SFV = 183697408, O_SFL = 183894016;
constexpr size_t DO_OMIX = 0, DO_QB = 134873088, DO_ACT01 = O_PFK * 4;

constexpr size_t SZ_W1K = 2097152;
constexpr size_t SZ_WUP = 11534336, SZ_WDN = 5767168, SZ_WINA = 6815744, SZ_WKV = 3670016, SZ_WMEM = 4194304;
constexpr size_t OFF_WINB = 0;
constexpr size_t OFF_WOUT23 = OFF_WINB + 2 * SZ_W1K;
constexpr size_t OFF_WUP23 = OFF_WOUT23 + 2 * SZ_W1K;
constexpr size_t OFF_WDN23 = OFF_WUP23 + 2 * SZ_WUP;
constexpr size_t OFF_H = OFF_WDN23 + 2 * SZ_WDN;
constexpr size_t SZ_H = (size_t)MR * 1024 * 2;
constexpr size_t OFF_RS = OFF_H + SZ_H;
constexpr size_t SZ_RS = (size_t)MR * 16 * 4;
constexpr size_t SZ_MEMKV = 8388608;
constexpr size_t OFF_MEMK_P = OFF_RS + SZ_RS, OFF_MEMVT_P = OFF_MEMK_P + SZ_MEMKV, OFF_MEMK_S = OFF_MEMVT_P + SZ_MEMKV, OFF_MEMVT_S = OFF_MEMK_S + SZ_MEMKV;
constexpr size_t SZ_KP = (size_t)NB * 4096 * 768 * 2, SZ_KS = (size_t)NB * LS * 768 * 2;
constexpr size_t OFF_KBUF_P = OFF_MEMVT_S + SZ_MEMKV, OFF_KBUF_S = OFF_KBUF_P + SZ_KP, OFF_VT_P = OFF_KBUF_S + SZ_KS, OFF_VT_S = OFF_VT_P + SZ_KP;
constexpr size_t OFF_C_P = OFF_VT_S + SZ_KS;
constexpr size_t OFF_C_S = OFF_C_P + (size_t)NB * 12 * 4096 * 4;
constexpr size_t OFF_OML = OFF_C_S + (size_t)NB * 12 * LS * 4;
constexpr size_t OFF_CTR = OFF_OML + 8192;
constexpr size_t OFF_XBAR = OFF_CTR + 256;
constexpr size_t OFF_ACTW = OFF_XBAR + 16384;
constexpr size_t SZ_ACT = (size_t)MR * 2816 * 2;
constexpr size_t SZ_X768 = (size_t)MR * 768 * 2;
constexpr size_t OFF_GB = OFF_ACTW;
constexpr size_t OFF_WINA = OFF_GB + (size_t)MR * 768 * 4;
constexpr size_t OFF_WKV = OFF_WINA + 2 * SZ_WINA;
constexpr size_t OFF_WMEM = OFF_WKV + SZ_WKV;
constexpr size_t OFF_WOUT01 = OFF_WMEM + SZ_WMEM;
constexpr size_t OFF_WUP01 = OFF_WOUT01 + 2 * SZ_W1K;
constexpr size_t OFF_WDN01 = OFF_WUP01 + 2 * SZ_WUP;
constexpr size_t OFF_MEMB = OFF_WDN01 + 2 * SZ_WDN;
constexpr size_t OFF_RSMEM = OFF_MEMB + 8388608;
constexpr size_t OFF_EARLY_END = OFF_RSMEM + 262144;
constexpr size_t OFF_PMQ = OFF_ACTW + SZ_ACT;
constexpr size_t WS_END = OFF_PMQ + (size_t)MR * 256 * 2;
static_assert(OFF_EARLY_END <= OFF_ACTW + SZ_ACT, "overlay overflow");
static_assert(WS_END <= (size_t)1073741824, "workspace too large");
constexpr size_t OFF_VB = OFF_KBUF_P, OFF_GATEB = OFF_VB + SZ_X768;
static_assert(OFF_GATEB + SZ_X768 <= OFF_C_P, "A-layer overlay overflow");
static_assert(DO_QB + SZ_X768 <= (size_t)O_YS * 4, "y scratch overflow");
static_assert(DO_ACT01 + SZ_ACT <= (size_t)O_PFL * 4, "act scratch overflow");

constexpr int NG = 24;
constexpr int LDS_BYTES = 131072 + 4096 + 256;

struct WJob { const float* W; const float* gain; bf16_t* Bt; int K, Ntrue, Np, kind; };
struct Params {
    const float* in[28];
    float* out;
    unsigned char* ws;
    WJob wj[21];
};

__device__ __forceinline__ unsigned pk_bf16(float lo, float hi) { unsigned r; asm("v_cvt_pk_bf16_f32 %0, %1, %2" : "=v"(r) : "v"(lo), "v"(hi)); return r; }
__device__ __forceinline__ int otid() { int t = threadIdx.x; asm volatile("" : "+v"(t)); return t; }
__device__ __forceinline__ unsigned xb_ld(unsigned* p)              { return __hip_atomic_load(p, __ATOMIC_RELAXED, __HIP_MEMORY_SCOPE_AGENT); }
__device__ __forceinline__ unsigned xb_add(unsigned* p, unsigned v) { return __hip_atomic_fetch_add(p, v, __ATOMIC_RELAXED, __HIP_MEMORY_SCOPE_AGENT); }
__device__ __forceinline__ float bf_lo(unsigned u) { return __uint_as_float(u << 16); }
__device__ __forceinline__ float bf_hi(unsigned u) { return __uint_as_float(u & 0xffff0000u); }
__device__ __forceinline__ float silu_f(float x) { return x * __builtin_amdgcn_rcpf(1.0f + __expf(-x)); }
__device__ __forceinline__ float lanex(float x, int src) { return __int_as_float(__builtin_amdgcn_ds_bpermute(src << 2, __float_as_int(x))); }
#define xor16(x) lanex((x), lane ^ 16)
#define xor32(x) lanex((x), lane ^ 32)
__device__ __forceinline__ bf16_t* wsb(const Params& P, size_t off) { return (bf16_t*)(P.ws + off); }
__device__ __forceinline__ float* wsf(const Params& P, size_t off) { return (float*)(P.ws + off); }
__device__ __forceinline__ bf16_t* outb(const Params& P, size_t off) { return (bf16_t*)((unsigned char*)P.out + off); }
__device__ __forceinline__ const bf16_t* w_out_ptr(const Params& P, int l) { return l < 2 ? wsb(P, OFF_WOUT01 + l * SZ_W1K) : wsb(P, OFF_WOUT23 + (l - 2) * SZ_W1K); }
__device__ __forceinline__ const bf16_t* w_up_ptr(const Params& P, int l) { return l < 2 ? wsb(P, OFF_WUP01 + l * SZ_WUP) : wsb(P, OFF_WUP23 + (l - 2) * SZ_WUP); }
__device__ __forceinline__ const bf16_t* w_dn_ptr(const Params& P, int l) { return l < 2 ? wsb(P, OFF_WDN01 + l * SZ_WDN) : wsb(P, OFF_WDN23 + (l - 2) * SZ_WDN); }
__device__ __forceinline__ bf16_t* act_ptr(const Params& P, int l) { return l < 2 ? outb(P, DO_ACT01) : wsb(P, OFF_ACTW); }

__device__ __forceinline__ int colmap(int kind, int n) {
    const int head = (n & ~255) + (((n >> 5) & 3) << 6) + (((n >> 7) & 1) << 5) + (n & 31);
    switch (kind) {
        case 0: return n;
        case 1: return head;
        case 2: return n < 3072 ? n : head;
        case 3: { const int pn = n >> 8, tc = n & 255; return (tc >> 7) * 2816 + pn * 128 + (tc & 127); }
        case 4: return n < 768 ? head : n;
        default: return n < 256 ? head : n;
    }
}

__device__ void prep_weights(const Params& P, LAS unsigned char* lds) {
    LAS bf16_t* tile = (LAS bf16_t*)lds;
    const int tid = otid();
    for (int j = 0; j < 21; ++j) {
        const float* W = P.wj[j].W; const float* gain = P.wj[j].gain; bf16_t* Bt = P.wj[j].Bt;
        const int K = P.wj[j].K, Ntrue = P.wj[j].Ntrue, Np = P.wj[j].Np, kind = P.wj[j].kind;
        const int ntn = Np >> 6, nt = ntn * (K >> 6);
        for (int t = blockIdx.x; t < nt; t += gridDim.x) {
            const int n0 = (t % ntn) << 6, k0 = (t / ntn) << 6;
            {
                const int kk = tid >> 3, nc = (tid & 7) << 3;
                const int col = colmap(kind, n0 + nc);
                const float gk = gain ? gain[k0 + kk] : 1.0f;
                const float* src = W + (size_t)(k0 + kk) * Ntrue + col;
                float x[8];
                if (col + 8 <= Ntrue) { const f32x4 a = __builtin_nontemporal_load((const f32x4*)src), b = __builtin_nontemporal_load((const f32x4*)(src + 4));
                    x[0] = a[0]; x[1] = a[1]; x[2] = a[2]; x[3] = a[3]; x[4] = b[0]; x[5] = b[1]; x[6] = b[2]; x[7] = b[3]; }
                else {
#pragma unroll
                    for (int i = 0; i < 8; ++i) x[i] = (col + i < Ntrue) ? src[i] : 0.0f; }
                u32x4 w; w.x = pk_bf16(x[0] * gk, x[1] * gk); w.y = pk_bf16(x[2] * gk, x[3] * gk); w.z = pk_bf16(x[4] * gk, x[5] * gk); w.w = pk_bf16(x[6] * gk, x[7] * gk);
                *(LAS u32x4*)(tile + kk * 72 + nc) = w;
            }
            __syncthreads();
            {
                const int nn = tid >> 3, kc = (tid & 7) << 3;
                unsigned short e[8];
#pragma unroll
                for (int i = 0; i < 8; ++i) e[i] = tile[(kc + i) * 72 + nn];
                u32x4 w; w.x = e[0] | ((unsigned)e[1] << 16); w.y = e[2] | ((unsigned)e[3] << 16); w.z = e[4] | ((unsigned)e[5] << 16); w.w = e[6] | ((unsigned)e[7] << 16);
                *(u32x4*)(Bt + (size_t)(n0 + nn) * K + k0 + kc) = w;
            }
            __syncthreads();
        }
    }
}

__device__ void transpose_tile(const float* src, size_t sks, bf16_t* dst, size_t dds, LAS unsigned char* lds) {
    LAS bf16_t* tile = (LAS bf16_t*)lds;
    const int tid = otid();
    {
        const int key = tid >> 3, dc = (tid & 7) << 3;
        const float* s = src + (size_t)key * sks + dc;
        const f32x4 a = __builtin_nontemporal_load((const f32x4*)s), b = __builtin_nontemporal_load((const f32x4*)(s + 4));
        u32x4 w; w.x = pk_bf16(a[0], a[1]); w.y = pk_bf16(a[2], a[3]); w.z = pk_bf16(b[0], b[1]); w.w = pk_bf16(b[2], b[3]);
        *(LAS u32x4*)(tile + key * 72 + dc) = w;
    }
    __syncthreads();
    {
        const int d = tid >> 3, kc = (tid & 7) << 3;
        unsigned short e[8];
#pragma unroll
        for (int i = 0; i < 8; ++i) e[i] = tile[(kc + i) * 72 + d];
        u32x4 w; w.x = e[0] | ((unsigned)e[1] << 16); w.y = e[2] | ((unsigned)e[3] << 16); w.z = e[4] | ((unsigned)e[5] << 16); w.w = e[6] | ((unsigned)e[7] << 16);
        *(u32x4*)(dst + (size_t)d * dds + kc) = w;
    }
    __syncthreads();
}

__device__ void prep_rows(const Params& P) {
    const int lane = otid() & 63, gw = blockIdx.x * 8 + (otid() >> 6), nw = gridDim.x * 8;
    for (int r = gw; r < MT + 4096; r += nw) {
        const float* src; bf16_t* dst; float* rs;
        if (r < MPR) { src = P.in[0] + (size_t)r * 1024; dst = wsb(P, OFF_H) + (size_t)r * 1024; rs = wsf(P, OFF_RS) + (size_t)r * 16; }
        else if (r < MT) { src = P.in[1] + (size_t)(r - MPR) * 1024; dst = wsb(P, OFF_H) + (size_t)r * 1024; rs = wsf(P, OFF_RS) + (size_t)r * 16; }
        else { const int rm = r - MT; src = P.in[2] + (size_t)rm * 1024; dst = wsb(P, OFF_MEMB) + (size_t)rm * 1024; rs = wsf(P, OFF_RSMEM) + (size_t)rm * 16; }
        float ss = 0.f;
#pragma unroll
        for (int i = 0; i < 4; ++i) {
            const f32x4 v = __builtin_nontemporal_load((const f32x4*)(src + i * 256 + lane * 4));
            u32x2 w; w.x = pk_bf16(v[0], v[1]); w.y = pk_bf16(v[2], v[3]);
            *(u32x2*)(dst + i * 256 + lane * 4) = w;
            const float a = bf_lo(w.x), b = bf_hi(w.x), c = bf_lo(w.y), d = bf_hi(w.y);
            ss += a * a + b * b + c * c + d * d;
        }
#pragma unroll
        for (int o = 32; o >= 1; o >>= 1) ss += lanex(ss, lane ^ o);
        if (lane < 16) rs[lane] = lane == 0 ? ss : 0.0f;
    }
}

__device__ void prep_misc(const Params& P, LAS unsigned char* lds) {
    const int tid = otid();
    if (blockIdx.x == 0) {
        for (int i = tid; i < 1536; i += 512) {
            float v = 1.0f;
            if (i >= 768) { const float l0 = P.in[12][i - 768], l1 = P.in[12][i]; v = 1.0f / (1.0f + __expf(l1 - l0)); }
            wsf(P, OFF_OML)[i] = v;
        }
        if (tid < 64) ((unsigned*)(P.ws + OFF_CTR))[tid] = 0u;
        for (int i = tid; i < 4096; i += 512) ((unsigned*)(P.ws + OFF_XBAR))[i] = 0u;
    }
    {
        const size_t n4 = (size_t)4 * 16 * 256 * 256 / 4;
        const f32x4* s = (const f32x4*)P.in[8]; u32x2* d = (u32x2*)wsb(P, OFF_MEMK_S);
        for (size_t i = (size_t)blockIdx.x * 512 + tid; i < n4; i += (size_t)gridDim.x * 512) { const f32x4 v = s[i]; u32x2 w; w.x = pk_bf16(v[0], v[1]); w.y = pk_bf16(v[2], v[3]); d[i] = w; }
    }
    for (int t = blockIdx.x; t < 4 * 16 * 4 * 4; t += gridDim.x) {
        const int kt = t & 3, hh = (t >> 2) & 3, lb = t >> 4;
        transpose_tile(P.in[9] + (((size_t)lb * 256 + kt * 64) * 4 + hh) * 64, 256, wsb(P, OFF_MEMVT_S) + (((size_t)lb * 4 + hh) * 64) * 256 + kt * 64, 256, lds);
    }
}

namespace pg8 {
constexpr int BM = 256, BK = 64, HALF = 128, HTB = HALF * BK * 2, STAGE_BYTES = 8 * HTB, NXCD = 8, WGM = 8;
__device__ __forceinline__ int lds_byte(int r, int c) { const int st = (r >> 4) * 2 + (c >> 5), rr = r & 15, cc = c & 31, ob = rr * 64 + cc * 2; return st * 1024 + (ob ^ (((ob >> 9) & 1) << 5)); }
__device__ __forceinline__ void stage_rc(int b, int& R, int& C) { const int st = b / 1024, sb = b % 1024, swz = sb ^ (((sb >> 9) & 1) << 5); R = (st >> 1) * 16 + swz / 64; C = (st & 1) * 32 + (swz % 64) / 2; }
__device__ __forceinline__ int perm32(int rho) { const int n = rho >> 4, i = rho & 15; return 8 * (i >> 2) + 4 * n + (i & 3); }
struct Unit { int pm, pn; };
struct Gemm { const bf16_t* A; const bf16_t* Bt; int M, N, K; };
struct Order {
    int nM, nN, nwg, G, c;
    __device__ void init(int M, int N, int G_, int c_) { nM = M / BM; nN = N / BM; nwg = nM * nN; G = G_; c = c_; }
    __device__ bool next(int i, Unit& u) const {
        const long L = (long)i * G + c; if (L >= nwg) return false;
        int wgid = (int)L; { const int q = nwg / NXCD, r = nwg % NXCD, xcd = wgid % NXCD, off = wgid / NXCD; wgid = (xcd < r ? xcd * (q + 1) : r * (q + 1) + (xcd - r) * q) + off; }
        const int nig = WGM * nN, gid = wgid / nig, fm = gid * WGM, gsz = (nM - fm) < WGM ? (nM - fm) : WGM;
        u.pm = fm + ((wgid % nig) % gsz); u.pn = (wgid % nig) / gsz; return true;
    }
};

template <class Epi>
__device__ __forceinline__ void gemm_phase(LAS unsigned char* lds, const Gemm g, const Order& S, const Epi& E) {
    const int tid = otid(), wid = __builtin_amdgcn_readfirstlane(tid >> 6), lane = tid & 63, wr = wid >> 2, wc = wid & 3, fr = lane & 15, fq = lane >> 4;
    const int K = g.K, nt = K / BK;
    unsigned voffA[2], voffB[2];
#pragma unroll
    for (int i = 0; i < 2; ++i) { int R, C; stage_rc(tid * 16 + i * 8192, R, C); const int Rb = (R & ~31) + perm32(R & 31);
        voffA[i] = (unsigned)(R * K + C) * 2u; voffB[i] = (unsigned)(Rb * K + C) * 2u; }
    const size_t kstep = (size_t)(BK * 2);
    const size_t hstep = (size_t)HALF * K * 2;
    const size_t tstep = 2 * hstep;
    const unsigned ldsw = (unsigned)wid * 1024u;
    const int aoff = lds_byte(wr * 64 + fr, fq * 8), boff = lds_byte(wc * 32 + fr, fq * 8);
#define PG8_SA(b, h) (((b) * 2 + (h)) * HTB)
#define PG8_SB(b, h) ((4 + (b) * 2 + (h)) * HTB)
#define PG8_STAGE(bufoff, gbase, voff) do { _Pragma("unroll") for (int _i = 0; _i < 2; ++_i) \
        __builtin_amdgcn_global_load_lds((const unsigned*)((const char*)(gbase) + (voff)[_i]), (LAS unsigned*)(lds + (bufoff) + ldsw + _i * 8192), 16, 0, 0); } while (0)
#define PG8_LDA(dst, b, h) do { _Pragma("unroll") for (int m = 0; m < 4; ++m) _Pragma("unroll") for (int k = 0; k < 2; ++k) dst[m][k] = *(const LAS bf16x8*)(lds + PG8_SA(b, h) + aoff + m * 2048 + k * 1024); } while (0)
#define PG8_LDB(dst, b, h) do { _Pragma("unroll") for (int n = 0; n < 2; ++n) _Pragma("unroll") for (int k = 0; k < 2; ++k) dst[n][k] = *(const LAS bf16x8*)(lds + PG8_SB(b, h) + boff + n * 2048 + k * 1024); } while (0)
#define PG8_MMA(ai, bj, At, Bt) do { __builtin_amdgcn_s_setprio(1); _Pragma("unroll") for (int m = 0; m < 4; ++m) _Pragma("unroll") for (int n = 0; n < 2; ++n) _Pragma("unroll") for (int k = 0; k < 2; ++k) \
        acc[ai][bj][m][n] = __builtin_amdgcn_mfma_f32_16x16x32_bf16(Bt[n][k], At[m][k], acc[ai][bj][m][n], 0, 0, 0); __builtin_amdgcn_s_setprio(0); } while (0)
#define PG8_WAIT_V(n) asm volatile("s_waitcnt vmcnt(" #n ")" ::: "memory")
#define PG8_WAIT_L(n) asm volatile("s_waitcnt lgkmcnt(" #n ")" ::: "memory")
#define PG8_BAR __builtin_amdgcn_s_barrier()
#define PG8_SCHED __builtin_amdgcn_sched_barrier(0)
    Unit cur, nxt; int ui = 0; int lastpm = -1;
    if (!S.next(0, cur)) return;
    f32x4 acc[2][2][4][2];
#pragma unroll
    for (int a = 0; a < 2; ++a)
#pragma unroll
        for (int b = 0; b < 2; ++b)
#pragma unroll
            for (int m = 0; m < 4; ++m)
#pragma unroll
                for (int n = 0; n < 2; ++n) acc[a][b][m][n] = (f32x4){0.f, 0.f, 0.f, 0.f};
    bf16x8 At[4][2], B0[2][2], B1[2][2];
    const char* cA = (const char*)g.A + (size_t)cur.pm * tstep; const char* cB = (const char*)g.Bt + (size_t)cur.pn * tstep;
    PG8_STAGE(PG8_SB(0, 0), cB, voffB); PG8_STAGE(PG8_SA(0, 0), cA, voffA); PG8_STAGE(PG8_SB(0, 1), cB + hstep, voffB); PG8_STAGE(PG8_SA(0, 1), cA + hstep, voffA);
    if (wr == 1) PG8_BAR;
    PG8_WAIT_V(4); PG8_BAR;
    PG8_STAGE(PG8_SB(1, 0), cB + kstep, voffB); PG8_STAGE(PG8_SA(1, 0), cA + kstep, voffA); PG8_STAGE(PG8_SB(1, 1), cB + hstep + kstep, voffB);
    PG8_WAIT_V(6); PG8_BAR;
    for (;;) {
        const bool has_next = S.next(ui + 1, nxt);
        const char* nA = has_next ? (const char*)g.A + (size_t)nxt.pm * tstep : cA; const char* nB = has_next ? (const char*)g.Bt + (size_t)nxt.pn * tstep : cB;
        for (int t = 0; t < nt; t += 2) {
            const bool last = (t == nt - 2);
            const char* a1 = cA + (size_t)(t + 1) * kstep;
            const char* a2 = last ? nA : cA + (size_t)(t + 2) * kstep; const char* b2 = last ? nB : cB + (size_t)(t + 2) * kstep;
            const char* a3 = a2 + kstep; const char* b3 = b2 + kstep;
            PG8_LDB(B0, 0, 0); PG8_SCHED; PG8_LDA(At, 0, 0); PG8_STAGE(PG8_SA(1, 1), a1 + hstep, voffA);
            PG8_WAIT_L(8); PG8_BAR; PG8_WAIT_L(0); PG8_MMA(0, 0, At, B0); PG8_BAR; PG8_SCHED;
            PG8_LDB(B1, 0, 1); PG8_STAGE(PG8_SB(0, 0), b2, voffB);
            PG8_BAR; PG8_WAIT_L(0); PG8_MMA(0, 1, At, B1); PG8_BAR;
            PG8_LDA(At, 0, 1); PG8_STAGE(PG8_SA(0, 0), a2, voffA);
            PG8_BAR; PG8_WAIT_L(0); PG8_MMA(1, 0, At, B0); PG8_BAR; PG8_SCHED;
            PG8_STAGE(PG8_SB(0, 1), b2 + hstep, voffB);
            PG8_WAIT_V(6); PG8_BAR; PG8_MMA(1, 1, At, B1); PG8_BAR;
            PG8_LDB(B0, 1, 0); PG8_SCHED; PG8_LDA(At, 1, 0); PG8_STAGE(PG8_SA(0, 1), a2 + hstep, voffA);
            PG8_WAIT_L(8); PG8_BAR; PG8_WAIT_L(0); PG8_MMA(0, 0, At, B0); PG8_BAR; PG8_SCHED;
            PG8_LDB(B1, 1, 1); PG8_STAGE(PG8_SB(1, 0), b3, voffB);
            PG8_BAR; PG8_WAIT_L(0); PG8_MMA(0, 1, At, B1); PG8_BAR;
            PG8_LDA(At, 1, 1); PG8_STAGE(PG8_SA(1, 0), a3, voffA);
            PG8_BAR; PG8_WAIT_L(0); PG8_MMA(1, 0, At, B0); PG8_BAR; PG8_SCHED;
            PG8_STAGE(PG8_SB(1, 1), b3 + hstep, voffB);
            PG8_WAIT_V(6); PG8_BAR; PG8_MMA(1, 1, At, B1); PG8_BAR;
        }
        E(acc, cur, wr, wc, fr, fq, lastpm);
        if (!has_next) break;
#pragma unroll
        for (int a = 0; a < 2; ++a)
#pragma unroll
            for (int b = 0; b < 2; ++b)
#pragma unroll
                for (int m = 0; m < 4; ++m)
#pragma unroll
                    for (int n = 0; n < 2; ++n) acc[a][b][m][n] = (f32x4){0.f, 0.f, 0.f, 0.f};
        cur = nxt; cA = nA; cB = nB; ++ui;
    }
    PG8_WAIT_V(0);
    if (wr == 0) PG8_BAR;
    PG8_BAR;
#undef PG8_SA
#undef PG8_SB
#undef PG8_STAGE
#undef PG8_LDA
#undef PG8_LDB
#undef PG8_MMA
#undef PG8_WAIT_V
#undef PG8_WAIT_L
#undef PG8_BAR
#undef PG8_SCHED
}
}

enum { M_INA = 0, M_INB = 1, M_OUT = 2, M_UP = 3, M_KV = 4, M_MEMKV = 5, M_FINAL = 6 };

__device__ __forceinline__ float rowscale(const float* rs) {
    const f32x4 a = *(const f32x4*)rs, b = *(const f32x4*)(rs + 4), c = *(const f32x4*)(rs + 8), d = *(const f32x4*)(rs + 12);
    const float s = (a[0] + a[1] + a[2] + a[3]) + (b[0] + b[1] + b[2] + b[3]) + (c[0] + c[1] + c[2] + c[3]) + (d[0] + d[1] + d[2] + d[3]);
    return __builtin_amdgcn_rsqf(s * (1.0f / 1024.0f) + EPS);
}
__device__ __forceinline__ void headnorm(const f32x4 (&v)[2][2], const float* gain, int fq, int lane, float mul, float (&o)[2][8]) {
    float ss = 0.f;
#pragma unroll
    for (int bj = 0; bj < 2; ++bj)
#pragma unroll
        for (int n = 0; n < 2; ++n)
#pragma unroll
            for (int j = 0; j < 4; ++j) ss += v[bj][n][j] * v[bj][n][j];
    ss += xor16(ss); ss += xor32(ss);
    const float rinv = __builtin_amdgcn_rsqf(ss * (1.0f / 64.0f) + EPS) * mul;
#pragma unroll
    for (int bj = 0; bj < 2; ++bj) {
        const f32x4 g0 = *(const f32x4*)(gain + 32 * bj + 8 * fq), g1 = *(const f32x4*)(gain + 32 * bj + 8 * fq + 4);
#pragma unroll
        for (int j = 0; j < 4; ++j) { o[bj][j] = v[bj][0][j] * rinv * g0[j]; o[bj][4 + j] = v[bj][1][j] * rinv * g1[j]; }
    }
}
__device__ __forceinline__ u32x4 pack8(const float (&x)[8]) { u32x4 w; w.x = pk_bf16(x[0], x[1]); w.y = pk_bf16(x[2], x[3]); w.z = pk_bf16(x[4], x[5]); w.w = pk_bf16(x[6], x[7]); return w; }

template <int MODE> struct Epi {
    const Params& P; int layer; LAS unsigned char* lds; int rowbase; static constexpr int mode = MODE;
    __device__ __forceinline__ void row(int r, int pn, int wc, int fq, int lane, f32x4 (&v)[2][2]) const {
        switch (mode) {
        case M_INA: {
            const int seg = pn / 3;
            if (seg < 4) {
#pragma unroll
                for (int bj = 0; bj < 2; ++bj) {
                    const int cs = (pn - seg * 3) * 256 + bj * 128 + wc * 32 + fq * 8; const size_t o = (size_t)r * 768 + cs;
                    float x[8];
#pragma unroll
                    for (int j = 0; j < 4; ++j) { x[j] = v[bj][0][j]; x[4 + j] = v[bj][1][j]; }
                    if (seg == 0 || seg == 3) {
#pragma unroll
                        for (int j = 0; j < 8; ++j) x[j] = silu_f(x[j]);
                        *(u32x4*)((seg == 0 ? outb(P, DO_QB) : wsb(P, OFF_GATEB)) + o) = pack8(x);
                    } else if (seg == 2) {
                        *(u32x4*)(wsb(P, OFF_VB) + o) = pack8(x);
                    } else {
                        const float* oml = wsf(P, OFF_OML) + layer * 768 + cs;
                        const f32x4 m0 = *(const f32x4*)oml, m1 = *(const f32x4*)(oml + 4);
                        f32x4 g0, g1;
#pragma unroll
                        for (int j = 0; j < 4; ++j) {
                            const float k0 = fminf(m0[j] * __builtin_amdgcn_rcpf(1.0f + __expf(x[j])), KMAX), k1 = fminf(m1[j] * __builtin_amdgcn_rcpf(1.0f + __expf(x[4 + j])), KMAX);
                            g0[j] = __logf(1.0f - k0); g1[j] = __logf(1.0f - k1);
                        }
                        float* gp = wsf(P, OFF_GB) + o; *(f32x4*)gp = g0; *(f32x4*)(gp + 4) = g1;
                    }
                }
            } else {
                float o[2][8]; headnorm(v, P.in[22] + layer * 64, fq, lane, QSCALE, o);
#pragma unroll
                for (int bj = 0; bj < 2; ++bj) *(u32x4*)(wsb(P, OFF_PMQ) + (size_t)r * 256 + wc * 64 + bj * 32 + fq * 8) = pack8(o[bj]);
            }
        } break;
        case M_INB: {
            float o[2][8];
            if (pn < 3) { headnorm(v, P.in[15] + (layer - 2) * 64, fq, lane, QSCALE, o);
#pragma unroll
                for (int bj = 0; bj < 2; ++bj) *(u32x4*)(outb(P, DO_QB) + (size_t)r * 768 + pn * 256 + wc * 64 + bj * 32 + fq * 8) = pack8(o[bj]);
            } else { headnorm(v, P.in[22] + layer * 64, fq, lane, QSCALE, o);
#pragma unroll
                for (int bj = 0; bj < 2; ++bj) *(u32x4*)(wsb(P, OFF_PMQ) + (size_t)r * 256 + wc * 64 + bj * 32 + fq * 8) = pack8(o[bj]);
            }
        } break;
        case M_OUT: case M_FINAL: {
            float ss = 0.f;
#pragma unroll
            for (int bj = 0; bj < 2; ++bj) {
                const int col = pn * 256 + bj * 128 + wc * 32 + fq * 8;
                bf16_t* hp = wsb(P, OFF_H) + (size_t)r * 1024 + col;
                const u32x4 hv = *(const u32x4*)hp;
                float x[8];
                x[0] = bf_lo(hv.x) + v[bj][0][0]; x[1] = bf_hi(hv.x) + v[bj][0][1]; x[2] = bf_lo(hv.y) + v[bj][0][2]; x[3] = bf_hi(hv.y) + v[bj][0][3];
                x[4] = bf_lo(hv.z) + v[bj][1][0]; x[5] = bf_hi(hv.z) + v[bj][1][1]; x[6] = bf_lo(hv.w) + v[bj][1][2]; x[7] = bf_hi(hv.w) + v[bj][1][3];
                if (mode == M_FINAL) {
                    float* yp = (r < MPR) ? P.out + O_YP + (size_t)r * 1024 + col : P.out + O_YS + (size_t)(r - MPR) * 1024 + col;
                    __builtin_nontemporal_store((f32x4){x[0], x[1], x[2], x[3]}, (f32x4*)yp); __builtin_nontemporal_store((f32x4){x[4], x[5], x[6], x[7]}, (f32x4*)(yp + 4));
                } else {
                    const u32x4 w = pack8(x); *(u32x4*)hp = w;
                    const float a0 = bf_lo(w.x), a1 = bf_hi(w.x), a2 = bf_lo(w.y), a3 = bf_hi(w.y), a4 = bf_lo(w.z), a5 = bf_hi(w.z), a6 = bf_lo(w.w), a7 = bf_hi(w.w);
                    ss += a0 * a0 + a1 * a1 + a2 * a2 + a3 * a3 + a4 * a4 + a5 * a5 + a6 * a6 + a7 * a7;
                }
            }
            if (mode == M_OUT) { ss += xor16(ss); ss += xor32(ss); if (fq == 0) wsf(P, OFF_RS)[(size_t)r * 16 + pn * 4 + wc] = ss; }
        } break;
        case M_UP: {
            float x[8];
#pragma unroll
            for (int j = 0; j < 4; ++j) { x[j] = silu_f(v[0][0][j]) * v[1][0][j]; x[4 + j] = silu_f(v[0][1][j]) * v[1][1][j]; }
            __builtin_nontemporal_store(pack8(x), (u32x4*)(act_ptr(P, layer) + (size_t)r * 2816 + pn * 128 + wc * 32 + fq * 8));
        } break;
        case M_KV: {
            const bool pr = r < MPR; const int rr = r - MPR;
            const int b = pr ? (r >> 12) : (rr >> 4), t = pr ? (r & 4095) : (rr & 15);
            if (pn < 3) {
                float o[2][8]; headnorm(v, P.in[19], fq, lane, 1.0f, o);
                const int head = pn * 4 + wc;
                float* fo = pr ? P.out + O_PFK + (size_t)r * 768 : P.out + O_SFK + (size_t)rr * 768;
                bf16_t* kb = pr ? wsb(P, OFF_KBUF_P) + (size_t)r * 768 : wsb(P, OFF_KBUF_S) + ((size_t)b * LS + 4096 + t) * 768;
#pragma unroll
                for (int bj = 0; bj < 2; ++bj) { const int c = head * 64 + bj * 32 + fq * 8;
                    __builtin_nontemporal_store((f32x4){o[bj][0], o[bj][1], o[bj][2], o[bj][3]}, (f32x4*)(fo + c)); __builtin_nontemporal_store((f32x4){o[bj][4], o[bj][5], o[bj][6], o[bj][7]}, (f32x4*)(fo + c + 4));
                    *(u32x4*)(kb + c) = pack8(o[bj]); }
            } else if (pn < 6) {
                float* fo = pr ? P.out + O_PFV + (size_t)r * 768 : P.out + O_SFV + (size_t)rr * 768;
#pragma unroll
                for (int bj = 0; bj < 2; ++bj) { const int c = (pn - 3) * 256 + bj * 128 + wc * 32 + fq * 8;
                    __builtin_nontemporal_store(v[bj][0], (f32x4*)(fo + c)); __builtin_nontemporal_store(v[bj][1], (f32x4*)(fo + c + 4));
                    const int head = c >> 6, d0 = c & 63;
                    bf16_t* vt = pr ? wsb(P, OFF_VT_P) + (((size_t)b * 12 + head) * 64 + d0) * 4096 + t : wsb(P, OFF_VT_S) + (((size_t)b * 12 + head) * 64 + d0) * LS + 4096 + t;
                    const size_t ds = pr ? 4096 : LS;
                    const u32x2 w0 = {pk_bf16(v[bj][0][0], v[bj][0][1]), pk_bf16(v[bj][0][2], v[bj][0][3])}, w1 = {pk_bf16(v[bj][1][0], v[bj][1][1]), pk_bf16(v[bj][1][2], v[bj][1][3])};
                    vt[0] = (bf16_t)(w0.x & 0xffff); vt[ds] = (bf16_t)(w0.x >> 16); vt[2 * ds] = (bf16_t)(w0.y & 0xffff); vt[3 * ds] = (bf16_t)(w0.y >> 16);
                    vt[4 * ds] = (bf16_t)(w1.x & 0xffff); vt[5 * ds] = (bf16_t)(w1.x >> 16); vt[6 * ds] = (bf16_t)(w1.y & 0xffff); vt[7 * ds] = (bf16_t)(w1.y >> 16); }
            } else if (wc == 0) {
                float* lo = pr ? P.out + O_PFL + (size_t)r * 12 : P.out + O_SFL + (size_t)rr * 12;
#pragma unroll
                for (int n = 0; n < 2; ++n)
#pragma unroll
                    for (int j = 0; j < 4; ++j) { const int c = fq * 8 + n * 4 + j;
                        if (c < 12) { const float x = v[0][n][j] + P.in[18][c]; lo[c] = fminf(x, 0.0f) - __logf(1.0f + __expf(-fabsf(x))); } }
            }
        } break;
        case M_MEMKV: {
            const int l = pn >> 1, b = r >> 8, m = r & 255;
            if ((pn & 1) == 0) {
                float o[2][8]; headnorm(v, P.in[23] + l * 64, fq, lane, 1.0f, o);
                const size_t base = ((size_t)l * 4096 + r) * 256;
#pragma unroll
                for (int bj = 0; bj < 2; ++bj) { const int c = wc * 64 + bj * 32 + fq * 8; float* fo = P.out + O_PMK + base + c;
                    *(f32x4*)fo = (f32x4){o[bj][0], o[bj][1], o[bj][2], o[bj][3]}; *(f32x4*)(fo + 4) = (f32x4){o[bj][4], o[bj][5], o[bj][6], o[bj][7]};
                    *(u32x4*)(wsb(P, OFF_MEMK_P) + base + c) = pack8(o[bj]); }
            } else {
                const size_t base = ((size_t)l * 4096 + r) * 256;
#pragma unroll
                for (int bj = 0; bj < 2; ++bj) { const int c = bj * 128 + wc * 32 + fq * 8; float* fo = P.out + O_PMV + base + c;
                    *(f32x4*)fo = v[bj][0]; *(f32x4*)(fo + 4) = v[bj][1];
                    const int head = c >> 6, d0 = c & 63;
                    bf16_t* vt = wsb(P, OFF_MEMVT_P) + ((((size_t)l * 16 + b) * 4 + head) * 64 + d0) * 256 + m;
                    const u32x2 w0 = {pk_bf16(v[bj][0][0], v[bj][0][1]), pk_bf16(v[bj][0][2], v[bj][0][3])}, w1 = {pk_bf16(v[bj][1][0], v[bj][1][1]), pk_bf16(v[bj][1][2], v[bj][1][3])};
                    vt[0] = (bf16_t)(w0.x & 0xffff); vt[256] = (bf16_t)(w0.x >> 16); vt[512] = (bf16_t)(w0.y & 0xffff); vt[768] = (bf16_t)(w0.y >> 16);
                    vt[1024] = (bf16_t)(w1.x & 0xffff); vt[1280] = (bf16_t)(w1.x >> 16); vt[1536] = (bf16_t)(w1.y & 0xffff); vt[1792] = (bf16_t)(w1.y >> 16); }
            }
        } break;
        }
    }
    __device__ __forceinline__ void operator()(const f32x4 (&acc)[2][2][4][2], const pg8::Unit& u, int wr, int wc, int fr_, int fq_, int& lastpm) const {
        int fr = fr_, fq = fq_; asm volatile("" : "+v"(fr), "+v"(fq));
        const float* rsb = (mode == M_MEMKV) ? wsf(P, OFF_RSMEM) : wsf(P, OFF_RS);
        constexpr bool scaled = !(MODE == M_OUT || MODE == M_FINAL);
        const int lane = fq * 16 + fr;
        float scv[8];
        if (scaled) {
            LAS float* sl = (LAS float*)(lds + 131072) + (wr * 4 + wc) * 128;
            if (u.pm != lastpm) {
                lastpm = u.pm;
#pragma unroll
                for (int h = 0; h < 2; ++h) {
                    const int idx = h * 64 + lane;
                    const int r = rowbase + u.pm * 256 + (idx >> 6) * 128 + wr * 64 + (idx & 63);
                    sl[idx] = rowscale(rsb + (size_t)r * 16);
                }
                __builtin_amdgcn_s_waitcnt(0xc07f);
            }
#pragma unroll
            for (int ai = 0; ai < 2; ++ai)
#pragma unroll
                for (int m = 0; m < 4; ++m) scv[ai * 4 + m] = sl[ai * 64 + m * 16 + fr];
        }
#pragma unroll
        for (int ai = 0; ai < 2; ++ai)
#pragma unroll
            for (int m = 0; m < 4; ++m) {
                const int r = rowbase + u.pm * 256 + ai * 128 + wr * 64 + m * 16 + fr;
                const float sc = scaled ? scv[ai * 4 + m] : 1.0f;
                f32x4 v[2][2];
#pragma unroll
                for (int bj = 0; bj < 2; ++bj)
#pragma unroll
                    for (int n = 0; n < 2; ++n) v[bj][n] = acc[ai][bj][m][n] * sc;
                row(r, u.pn, wc, fq, lane, v);
            }
    }
};

__device__ __forceinline__ void run_gemm(const Params& P, LAS unsigned char* lds, const bf16_t* A, const bf16_t* Bt, int M, int N, int K, int mode, int layer, int G, int c, int rowbase) {
    pg8::Gemm g; g.A = A; g.Bt = Bt; g.M = M; g.N = N; g.K = K;
    pg8::Order S; S.init(M, N, G, c);
    switch (mode) {
        case M_INA: { Epi<M_INA> E{P, layer, lds, rowbase}; pg8::gemm_phase(lds, g, S, E); } break;
        case M_INB: { Epi<M_INB> E{P, layer, lds, rowbase}; pg8::gemm_phase(lds, g, S, E); } break;
        case M_OUT: { Epi<M_OUT> E{P, layer, lds, rowbase}; pg8::gemm_phase(lds, g, S, E); } break;
        case M_UP: { Epi<M_UP> E{P, layer, lds, rowbase}; pg8::gemm_phase(lds, g, S, E); } break;
        case M_KV: { Epi<M_KV> E{P, layer, lds, rowbase}; pg8::gemm_phase(lds, g, S, E); } break;
        case M_MEMKV: { Epi<M_MEMKV> E{P, layer, lds, rowbase}; pg8::gemm_phase(lds, g, S, E); } break;
        default: { Epi<M_FINAL> E{P, layer, lds, rowbase}; pg8::gemm_phase(lds, g, S, E); } break;
    }
}

#define MFMA32(a, b, c) __builtin_amdgcn_mfma_f32_32x32x16_bf16((a), (b), (c), 0, 0, 0)

template <int NQB, bool FOX>
__device__ __forceinline__ void attn_wave(const bf16_t* __restrict__ Q, int ldq, int qpos0, const bf16_t* __restrict__ K, int ldk,
                                          const bf16_t* __restrict__ VT, int ldv, const float* __restrict__ cb, int tile_beg, int tile_end,
                                          f32x16 (&O)[NQB][2], float (&mrow)[NQB], float (&lrow)[NQB]) {
    const int lane = otid() & 63, r = lane & 31, hh = lane >> 5;
    bf16x8 qf[NQB][4];
#pragma unroll
    for (int qb = 0; qb < NQB; ++qb)
#pragma unroll
        for (int ks = 0; ks < 4; ++ks) qf[qb][ks] = *(const bf16x8*)(Q + (size_t)(qb * 32 + r) * ldq + ks * 16 + hh * 8);
#pragma unroll
    for (int qb = 0; qb < NQB; ++qb) { mrow[qb] = -1e30f; lrow[qb] = 0.f;
#pragma unroll
        for (int db = 0; db < 2; ++db)
#pragma unroll
            for (int i = 0; i < 16; ++i) O[qb][db][i] = 0.f; }
    if (tile_beg >= tile_end) return;
    bf16x8 kf[4]; u32x2 vlo[2][2], vhi[2][2]; f32x4 cbv[4];
    const bf16_t* kp = K + (size_t)r * ldk + hh * 8;
    const bf16_t* vp0 = VT + (size_t)r * ldv + 4 * hh;
    const bf16_t* vp1 = VT + (size_t)(32 + r) * ldv + 4 * hh;
#define ATT_LOADK(kt) do { _Pragma("unroll") for (int ks = 0; ks < 4; ++ks) kf[ks] = *(const bf16x8*)(kp + (size_t)(kt) * 32 * ldk + ks * 16); } while (0)
#define ATT_LOADC(kt) do { if (FOX) { _Pragma("unroll") for (int g = 0; g < 4; ++g) cbv[g] = *(const f32x4*)(cb + (kt) * 32 + 8 * g + 4 * hh); } } while (0)
#define ATT_LOADV(kt) do { _Pragma("unroll") for (int s = 0; s < 2; ++s) { \
        vlo[0][s] = *(const u32x2*)(vp0 + (kt) * 32 + 16 * s); vhi[0][s] = *(const u32x2*)(vp0 + (kt) * 32 + 16 * s + 8); \
        vlo[1][s] = *(const u32x2*)(vp1 + (kt) * 32 + 16 * s); vhi[1][s] = *(const u32x2*)(vp1 + (kt) * 32 + 16 * s + 8); } } while (0)
    ATT_LOADK(tile_beg); ATT_LOADC(tile_beg); ATT_LOADV(tile_beg);
    for (int kt = tile_beg; kt < tile_end; ++kt) {
        f32x16 S[NQB];
#pragma unroll
        for (int qb = 0; qb < NQB; ++qb) {
#pragma unroll
            for (int i = 0; i < 16; ++i) S[qb][i] = 0.f;
#pragma unroll
            for (int ks = 0; ks < 4; ++ks) S[qb] = MFMA32(kf[ks], qf[qb][ks], S[qb]);
        }
        const int ktn = (kt + 1 < tile_end) ? kt + 1 : kt;
        ATT_LOADK(ktn);
        bf16x8 pf[NQB][2];
#pragma unroll
        for (int qb = 0; qb < NQB; ++qb) {
            float mx = -1e30f;
            if (FOX) {
                const int qpos = qpos0 + qb * 32 + r;
#pragma unroll
                for (int i = 0; i < 16; ++i) { const int key = kt * 32 + 8 * (i >> 2) + 4 * hh + (i & 3);
                    const float s = S[qb][i] - LOG2E * cbv[i >> 2][i & 3]; S[qb][i] = (key <= qpos) ? s : -1e30f; }
            }
#pragma unroll
            for (int i = 0; i < 16; ++i) mx = fmaxf(mx, S[qb][i]);
            mx = fmaxf(mx, xor32(mx));
            const float mnew = fmaxf(mrow[qb], mx);
            const float alpha = __builtin_amdgcn_exp2f(mrow[qb] - mnew);
            mrow[qb] = mnew;
            float ls = 0.f;
#pragma unroll
            for (int i = 0; i < 16; ++i) { S[qb][i] = __builtin_amdgcn_exp2f(S[qb][i] - mnew); ls += S[qb][i]; }
            lrow[qb] = lrow[qb] * alpha + ls;
#pragma unroll
            for (int db = 0; db < 2; ++db)
#pragma unroll
                for (int i = 0; i < 16; ++i) O[qb][db][i] *= alpha;
#pragma unroll
            for (int s = 0; s < 2; ++s) { u32x4 w; w.x = pk_bf16(S[qb][8 * s], S[qb][8 * s + 1]); w.y = pk_bf16(S[qb][8 * s + 2], S[qb][8 * s + 3]); w.z = pk_bf16(S[qb][8 * s + 4], S[qb][8 * s + 5]); w.w = pk_bf16(S[qb][8 * s + 6], S[qb][8 * s + 7]);
                pf[qb][s] = __builtin_bit_cast(bf16x8, w); }
        }
        ATT_LOADC(ktn);
#pragma unroll
        for (int db = 0; db < 2; ++db)
#pragma unroll
            for (int s = 0; s < 2; ++s) { u32x4 w; w.x = vlo[db][s].x; w.y = vlo[db][s].y; w.z = vhi[db][s].x; w.w = vhi[db][s].y; const bf16x8 vf = __builtin_bit_cast(bf16x8, w);
#pragma unroll
                for (int qb = 0; qb < NQB; ++qb) O[qb][db] = MFMA32(vf, pf[qb][s], O[qb][db]); }
        ATT_LOADV(ktn);
    }
#undef ATT_LOADK
#undef ATT_LOADC
#undef ATT_LOADV
}

template <int NQB>
__device__ __forceinline__ void attn_store(f32x16 (&O)[NQB][2], float (&lrow)[NQB], bf16_t* dst, size_t ld, int nvalid) {
    const int lane = otid() & 63, r = lane & 31, hh = lane >> 5;
#pragma unroll
    for (int qb = 0; qb < NQB; ++qb) {
        const float l = lrow[qb] + xor32(lrow[qb]); const float inv = 1.0f / l;
        if (qb * 32 + r < nvalid) {
#pragma unroll
            for (int db = 0; db < 2; ++db)
#pragma unroll
                for (int g = 0; g < 4; ++g) { u32x2 w; w.x = pk_bf16(O[qb][db][4 * g] * inv, O[qb][db][4 * g + 1] * inv); w.y = pk_bf16(O[qb][db][4 * g + 2] * inv, O[qb][db][4 * g + 3] * inv);
                    *(u32x2*)(dst + (size_t)(qb * 32 + r) * ld + db * 32 + g * 8 + hh * 4) = w; }
        }
    }
}

__device__ void mem_unit(const Params& P, int layer, int u) {
    if (u < 4096) {
        const int head = u & 3, qblk = u >> 2, row0 = qblk * 64, b = row0 >> 12;
        f32x16 O[2][2]; float m[2], l[2];
        attn_wave<2, false>(wsb(P, OFF_PMQ) + (size_t)row0 * 256 + head * 64, 256, 0, wsb(P, OFF_MEMK_P) + ((size_t)(layer * 16 + b) * 256) * 256 + head * 64, 256,
                            wsb(P, OFF_MEMVT_P) + (((size_t)(layer * 16 + b) * 4 + head) * 64) * 256, 256, nullptr, 0, 8, O, m, l);
        attn_store<2>(O, l, outb(P, DO_OMIX) + (size_t)row0 * 1024 + 768 + head * 64, 1024, 64);
    } else {
        const int v = u - 4096, head = v & 3, b = v >> 2, row0 = MPR + b * 16;
        f32x16 O[1][2]; float m[1], l[1];
        attn_wave<1, false>(wsb(P, OFF_PMQ) + (size_t)row0 * 256 + head * 64, 256, 0, wsb(P, OFF_MEMK_S) + ((size_t)(layer * 16 + b) * 256) * 256 + head * 64, 256,
                            wsb(P, OFF_MEMVT_S) + (((size_t)(layer * 16 + b) * 4 + head) * 64) * 256, 256, nullptr, 0, 8, O, m, l);
        attn_store<1>(O, l, outb(P, DO_OMIX) + (size_t)row0 * 1024 + 768 + head * 64, 1024, 16);
    }
}

__device__ void fox_prompt_unit(const Params& P, int u) {
    const int grp = u / 1536, idx = u - grp * 1536, bh = idx >> 3, qb64 = 63 - (grp * 8 + (idx & 7));
    const int b = bh / 12, head = bh - b * 12;
    f32x16 O[2][2]; float m[2], l[2];
    const size_t row0 = (size_t)b * 4096 + qb64 * 64;
    attn_wave<2, true>(outb(P, DO_QB) + row0 * 768 + head * 64, 768, qb64 * 64, wsb(P, OFF_KBUF_P) + (size_t)b * 4096 * 768 + head * 64, 768,
                       wsb(P, OFF_VT_P) + ((size_t)bh * 64) * 4096, 4096, wsf(P, OFF_C_P) + (size_t)bh * 4096, 0, 2 * qb64 + 2, O, m, l);
    attn_store<2>(O, l, outb(P, DO_OMIX) + row0 * 1024 + head * 64, 1024, 64);
}


__device__ void fox_prompt_wg(const Params& P, int u, LAS unsigned char* lds) {
    const int tid = otid(), w = tid >> 6, lane = tid & 63, r = lane & 31, hh = lane >> 5;
    const int Qb = 7 - u / 192, bh = u % 192, b = bh / 12, head = bh - b * 12;
    LAS bf16_t* KB = (LAS bf16_t*)lds;
    LAS bf16_t* VB = (LAS bf16_t*)(lds + 18432);
    LAS float* BB = (LAS float*)(lds + 36864);
    const bf16_t* Kg = wsb(P, OFF_KBUF_P) + (size_t)b * 4096 * 768 + head * 64;
    const bf16_t* Vg = wsb(P, OFF_VT_P) + (size_t)bh * 64 * 4096;
    const float* Cg = wsf(P, OFF_C_P) + (size_t)bh * 4096;
    const size_t row0 = (size_t)b * 4096 + 512 * Qb + 64 * w;
    const bf16_t* Qg = outb(P, DO_QB) + row0 * 768 + head * 64;
    bf16x8 qf[2][4];
#pragma unroll
    for (int qb = 0; qb < 2; ++qb)
#pragma unroll
        for (int ks = 0; ks < 4; ++ks) qf[qb][ks] = *(const bf16x8*)(Qg + (size_t)(qb * 32 + r) * 768 + ks * 16 + hh * 8);
    f32x16 O[2][2]; float mref[2], lrow[2];
#pragma unroll
    for (int qb = 0; qb < 2; ++qb) { mref[qb] = 16.0f - LOG2E * Cg[512 * Qb + 64 * w + 32 * qb + r]; lrow[qb] = 0.f;
#pragma unroll
        for (int db = 0; db < 2; ++db)
#pragma unroll
            for (int i = 0; i < 16; ++i) O[qb][db][i] = 0.f; }
    const int nt = 8 * Qb + 8, mylast = 8 * Qb + w;
    const int skey = tid >> 3, sc = tid & 7, vpos = 16 * (sc >> 1) + 4 * (sc & 1);
    u32x4 kreg, vreg; float breg = 0.f;
#define FX_GLOAD(t) do { kreg = *(const u32x4*)(Kg + (size_t)((t) * 64 + skey) * 768 + sc * 8); vreg = *(const u32x4*)(Vg + (size_t)skey * 4096 + (t) * 64 + sc * 8); \
        if (tid < 64) breg = -LOG2E * Cg[(t) * 64 + tid]; } while (0)
#define FX_LSTORE(buf) do { *(LAS u32x4*)(KB + (buf) * 4608 + skey * 72 + sc * 8) = kreg; \
        *(LAS u32x2*)(VB + (buf) * 4608 + skey * 72 + vpos) = (u32x2){vreg.x, vreg.y}; *(LAS u32x2*)(VB + (buf) * 4608 + skey * 72 + vpos + 8) = (u32x2){vreg.z, vreg.w}; \
        if (tid < 64) BB[(buf) * 64 + tid] = breg; } while (0)
    int t0 = 0, myfirst = 0;
    {
        LAS int* slot = (LAS int*)(lds + 131072 + 2560);
        const float cq0 = Cg[512 * Qb + 64 * w];
        const bool need = (lane < nt) ? (LOG2E * (Cg[64 * lane + 63] - cq0) < 64.0f) : true;
        const unsigned long long m = __builtin_amdgcn_ballot_w64(need);
        myfirst = __builtin_amdgcn_readfirstlane((int)__builtin_ctzll(m));
        if (w == 0 && lane == 0) *slot = myfirst;
        __syncthreads();
        t0 = *slot;
        __syncthreads();
    }
    FX_GLOAD(t0); FX_LSTORE(0);
    __syncthreads();
    for (int t = t0; t < nt; ++t) {
        const int cur = (t - t0) & 1;
        if (t + 1 < nt) FX_GLOAD(t + 1);
        if (t >= myfirst && t <= mylast) {
            f32x16 S[2][2];
#pragma unroll
            for (int kb = 0; kb < 2; ++kb) {
                bf16x8 kf[4];
#pragma unroll
                for (int ks = 0; ks < 4; ++ks) kf[ks] = *(const LAS bf16x8*)(KB + cur * 4608 + (32 * kb + r) * 72 + 16 * ks + 8 * hh);
#pragma unroll
                for (int g = 0; g < 4; ++g) { const f32x4 bv = *(const LAS f32x4*)(BB + cur * 64 + 32 * kb + 8 * g + 4 * hh);
#pragma unroll
                    for (int j = 0; j < 4; ++j) { S[0][kb][4 * g + j] = bv[j]; S[1][kb][4 * g + j] = bv[j]; } }
#pragma unroll
                for (int qb = 0; qb < 2; ++qb) {
#pragma unroll
                    for (int ks = 0; ks < 4; ++ks) S[qb][kb] = MFMA32(kf[ks], qf[qb][ks], S[qb][kb]);
                }
            }
            bf16x8 pf[2][4];
#pragma unroll
            for (int qb = 0; qb < 2; ++qb) {
                if (t == mylast) {
                    const int qrel = 32 * qb + r;
#pragma unroll
                    for (int kb = 0; kb < 2; ++kb)
#pragma unroll
                        for (int i = 0; i < 16; ++i) { const int krel = 32 * kb + 8 * (i >> 2) + 4 * hh + (i & 3); if (krel > qrel) S[qb][kb][i] = -1e30f; }
                }
                float ls = 0.f;
#pragma unroll
                for (int kb = 0; kb < 2; ++kb)
#pragma unroll
                    for (int i = 0; i < 16; ++i) { S[qb][kb][i] = __builtin_amdgcn_exp2f(S[qb][kb][i] - mref[qb]); ls += S[qb][kb][i]; }
                lrow[qb] += ls;
#pragma unroll
                for (int kb = 0; kb < 2; ++kb)
#pragma unroll
                    for (int s = 0; s < 2; ++s) { u32x4 wv; wv.x = pk_bf16(S[qb][kb][8 * s], S[qb][kb][8 * s + 1]); wv.y = pk_bf16(S[qb][kb][8 * s + 2], S[qb][kb][8 * s + 3]);
                        wv.z = pk_bf16(S[qb][kb][8 * s + 4], S[qb][kb][8 * s + 5]); wv.w = pk_bf16(S[qb][kb][8 * s + 6], S[qb][kb][8 * s + 7]); pf[qb][2 * kb + s] = __builtin_bit_cast(bf16x8, wv); }
            }
#pragma unroll
            for (int db = 0; db < 2; ++db)
#pragma unroll
                for (int s4 = 0; s4 < 4; ++s4) {
                    const bf16x8 vf = *(const LAS bf16x8*)(VB + cur * 4608 + (32 * db + r) * 72 + 16 * s4 + 8 * hh);
#pragma unroll
                    for (int qb = 0; qb < 2; ++qb) O[qb][db] = MFMA32(vf, pf[qb][s4], O[qb][db]);
                }
        }
        if (t + 1 < nt) FX_LSTORE(cur ^ 1);
        __syncthreads();
    }
#undef FX_GLOAD
#undef FX_LSTORE
    attn_store<2>(O, lrow, outb(P, DO_OMIX) + row0 * 1024 + head * 64, 1024, 64);
}

__device__ void fox_sample_unit(const Params& P, int bh, LAS unsigned char* lds) {
    const int tid = otid(), w = tid >> 6, lane = tid & 63, r = lane & 31, hh = lane >> 5;
    const int b = bh / 12, head = bh - b * 12;
    const size_t row0 = (size_t)MPR + b * 16;
    f32x16 O[1][2]; float m[1], l[1];
    const int tb = w * 17, te = (tb + 17 < 129) ? tb + 17 : 129;
    attn_wave<1, true>(outb(P, DO_QB) + row0 * 768 + head * 64, 768, 4096, wsb(P, OFF_KBUF_S) + (size_t)b * LS * 768 + head * 64, 768,
                       wsb(P, OFF_VT_S) + ((size_t)bh * 64) * LS, LS, wsf(P, OFF_C_S) + (size_t)bh * LS, tb, te, O, m, l);
    LAS float* OL = (LAS float*)lds; LAS float* ML = (LAS float*)(lds + 65536); LAS float* LL = (LAS float*)(lds + 65536 + 1024);
    const float lt = l[0] + xor32(l[0]);
#pragma unroll
    for (int db = 0; db < 2; ++db)
#pragma unroll
        for (int i = 0; i < 16; ++i) OL[(w * 64 + db * 32 + 8 * (i >> 2) + 4 * hh + (i & 3)) * 32 + r] = O[0][db][i];
    if (hh == 0) { ML[w * 32 + r] = m[0]; LL[w * 32 + r] = lt; }
    __syncthreads();
    {
        const int q = tid & 15, dp = tid >> 4;
        float M = -1e30f;
#pragma unroll
        for (int x = 0; x < 8; ++x) M = fmaxf(M, ML[x * 32 + q]);
        float L = 0.f, o0 = 0.f, o1 = 0.f;
#pragma unroll
        for (int x = 0; x < 8; ++x) { const float wg = __builtin_amdgcn_exp2f(ML[x * 32 + q] - M); L += wg * LL[x * 32 + q];
            o0 += wg * OL[(x * 64 + 2 * dp) * 32 + q]; o1 += wg * OL[(x * 64 + 2 * dp + 1) * 32 + q]; }
        const float inv = 1.0f / L;
        *(unsigned*)(outb(P, DO_OMIX) + (row0 + q) * 1024 + head * 64 + 2 * dp) = pk_bf16(o0 * inv, o1 * inv);
    }
    __syncthreads();
}

constexpr int HG_QT = 0, HG_KT = 17408, HG_KTT = 34816, HG_VTT = 53248, HG_PP = 71680, HG_ST = 80896, HG_TOT = 115712, HG_ERHO = 119808, HG_ELAST = 120320, HG_RED = 120832;

__device__ void hgrn_unit(const Params& P, LAS unsigned char* lds, int layer, int path, int b, int hd) {
    const int tid = otid(), w = tid >> 6, lane = tid & 63, r = lane & 31, hh = lane >> 5;
    const int kp = tid & 63, te = w;
    const int nch = path ? 1 : 64, tvalid = path ? 16 : 64;
    const size_t row0 = path ? (size_t)MPR + b * 16 : (size_t)b * 4096;
    const int col0 = hd * 128;
    const int vb = w & 3, tb = w >> 2, kb0 = 2 * (w >> 2);
    const bf16_t* QBp = outb(P, DO_QB); const bf16_t* VBp = wsb(P, OFF_VB); const bf16_t* GTp = wsb(P, OFF_GATEB); const float* GBp = wsf(P, OFF_GB);
    bf16_t* OM = outb(P, DO_OMIX);
    LAS bf16_t* QT = (LAS bf16_t*)(lds + HG_QT); LAS bf16_t* KT = (LAS bf16_t*)(lds + HG_KT); LAS bf16_t* KTT = (LAS bf16_t*)(lds + HG_KTT);
    LAS bf16_t* VTT = (LAS bf16_t*)(lds + HG_VTT); LAS bf16_t* PP = (LAS bf16_t*)(lds + HG_PP); LAS bf16_t* ST = (LAS bf16_t*)(lds + HG_ST);
    LAS float* TOT = (LAS float*)(lds + HG_TOT); LAS float* ERHO = (LAS float*)(lds + HG_ERHO); LAS float* ELAST = (LAS float*)(lds + HG_ELAST); LAS float* RED = (LAS float*)(lds + HG_RED);

    f32x16 accS[2];
    if (path) {
        const float* st = P.in[layer == 0 ? 3 : 4] + ((size_t)(b * 6 + hd) * 128) * 128;
#pragma unroll
        for (int jb = 0; jb < 2; ++jb)
#pragma unroll
            for (int i = 0; i < 16; ++i) accS[jb][i] = st[(size_t)(32 * (kb0 + jb) + 8 * (i >> 2) + 4 * hh + (i & 3)) * 128 + 32 * vb + r];
    } else {
#pragma unroll
        for (int jb = 0; jb < 2; ++jb)
#pragma unroll
            for (int i = 0; i < 16; ++i) accS[jb][i] = 0.f;
    }
    f32x4 gnv[4];
#pragma unroll
    for (int g = 0; g < 4; ++g) gnv[g] = *(const f32x4*)(P.in[13] + layer * 128 + 32 * vb + 8 * g + 4 * hh);

    f32x2 gq[8]; unsigned qq[8], vv[8]; u32x2 gt[4];
#define HG_LOAD(c) do { _Pragma("unroll") for (int i = 0; i < 8; ++i) { const int t = 8 * te + i; \
        if (t < tvalid) { const size_t o = (row0 + (size_t)(c) * 64 + t) * 768 + col0 + 2 * kp; gq[i] = *(const f32x2*)(GBp + o); qq[i] = *(const unsigned*)(QBp + o); vv[i] = *(const unsigned*)(VBp + o); } \
        else { gq[i] = (f32x2){0.f, 0.f}; qq[i] = 0u; vv[i] = 0u; } } } while (0)
#define HG_LOADG(c) do { const int t = 32 * tb + r; _Pragma("unroll") for (int g = 0; g < 4; ++g) { \
        if (t < tvalid) gt[g] = *(const u32x2*)(GTp + (row0 + (size_t)(c) * 64 + t) * 768 + col0 + 32 * vb + 8 * g + 4 * hh); else gt[g] = (u32x2){0u, 0u}; } } while (0)
    HG_LOAD(0);
    for (int c = 0; c < nch; ++c) {
        f32x2 bl[8];
        { f32x2 run = {0.f, 0.f};
#pragma unroll
          for (int i = 0; i < 8; ++i) { run += gq[i]; bl[i] = run; }
          *(LAS f32x2*)(TOT + te * 128 + 2 * kp) = run; }
        __syncthreads();
        {
            f32x2 pre = {0.f, 0.f}, rho = {0.f, 0.f}, bla = {0.f, 0.f};
#pragma unroll
            for (int e = 0; e < 8; ++e) { const f32x2 tv = *(const LAS f32x2*)(TOT + e * 128 + 2 * kp); if (e < te) pre += tv; if (e < 4) rho += tv; bla += tv; }
            unsigned k0p[4], k1p[4], v0p[4], v1p[4];
            float kt0[8], kt1[8];
#pragma unroll
            for (int i = 0; i < 8; ++i) {
                const int t = 8 * te + i;
                const f32x2 bb = pre + bl[i];
                const float eq0 = __expf(fminf(bb[0] - rho[0], 80.f)), eq1 = __expf(fminf(bb[1] - rho[1], 80.f));
                const float ek0 = __expf(fminf(rho[0] - bb[0], 80.f)), ek1 = __expf(fminf(rho[1] - bb[1], 80.f));
                const float kk0 = 1.0f - __expf(gq[i][0]), kk1 = 1.0f - __expf(gq[i][1]);
                const float q0 = bf_lo(qq[i]) * eq0, q1 = bf_hi(qq[i]) * eq1;
                kt0[i] = kk0 * ek0; kt1[i] = kk1 * ek1;
                *(LAS unsigned*)(QT + t * 136 + 2 * kp) = pk_bf16(q0, q1);
                *(LAS unsigned*)(KT + t * 136 + 2 * kp) = pk_bf16(kt0[i], kt1[i]);
            }
#pragma unroll
            for (int i = 0; i < 4; ++i) { k0p[i] = pk_bf16(kt0[2 * i], kt0[2 * i + 1]); k1p[i] = pk_bf16(kt1[2 * i], kt1[2 * i + 1]);
                v0p[i] = (vv[2 * i] & 0xffffu) | (vv[2 * i + 1] << 16); v1p[i] = (vv[2 * i] >> 16) | (vv[2 * i + 1] & 0xffff0000u); }
            *(LAS u32x4*)(KTT + (2 * kp) * 72 + 8 * te) = (u32x4){k0p[0], k0p[1], k0p[2], k0p[3]};
            *(LAS u32x4*)(KTT + (2 * kp + 1) * 72 + 8 * te) = (u32x4){k1p[0], k1p[1], k1p[2], k1p[3]};
            *(LAS u32x4*)(VTT + (2 * kp) * 72 + 8 * te) = (u32x4){v0p[0], v0p[1], v0p[2], v0p[3]};
            *(LAS u32x4*)(VTT + (2 * kp + 1) * 72 + 8 * te) = (u32x4){v1p[0], v1p[1], v1p[2], v1p[3]};
            if (te == 0) { *(LAS f32x2*)(ERHO + 2 * kp) = (f32x2){__expf(rho[0]), __expf(rho[1])}; *(LAS f32x2*)(ELAST + 2 * kp) = (f32x2){__expf(bla[0] - rho[0]), __expf(bla[1] - rho[1])}; }
        }
        if (c + 1 < nch) HG_LOAD(c + 1);
        HG_LOADG(c);
        __syncthreads();
#pragma unroll
        for (int jb = 0; jb < 2; ++jb)
#pragma unroll
            for (int g = 0; g < 4; ++g) {
                const f32x4 er = *(const LAS f32x4*)(ERHO + 32 * (kb0 + jb) + 8 * g + 4 * hh);
#pragma unroll
                for (int j = 0; j < 4; ++j) accS[jb][4 * g + j] *= er[j];
                *(LAS u32x2*)(ST + (32 * vb + r) * 136 + 32 * (kb0 + jb) + 8 * g + 4 * hh) = (u32x2){pk_bf16(accS[jb][4 * g], accS[jb][4 * g + 1]), pk_bf16(accS[jb][4 * g + 2], accS[jb][4 * g + 3])};
            }
        __syncthreads();
        if (w < 3) {
            const int ptb = w ? 1 : 0, psb = (w == 2) ? 1 : 0;
            f32x16 ap;
#pragma unroll
            for (int i = 0; i < 16; ++i) ap[i] = 0.f;
#pragma unroll
            for (int ks = 0; ks < 8; ++ks) {
                const bf16x8 a = *(const LAS bf16x8*)(KT + (32 * psb + r) * 136 + ks * 16 + 8 * hh);
                const bf16x8 bq = *(const LAS bf16x8*)(QT + (32 * ptb + r) * 136 + ks * 16 + 8 * hh);
                ap = MFMA32(a, bq, ap);
            }
            const int t = 32 * ptb + r;
#pragma unroll
            for (int g = 0; g < 4; ++g) { float x[4];
#pragma unroll
                for (int j = 0; j < 4; ++j) { const int s = 32 * psb + 8 * g + 4 * hh + j; x[j] = (s <= t) ? ap[4 * g + j] : 0.f; }
                *(LAS u32x2*)(PP + t * 72 + 32 * psb + 8 * g + 4 * hh) = (u32x2){pk_bf16(x[0], x[1]), pk_bf16(x[2], x[3])}; }
        }
        f32x16 ao;
#pragma unroll
        for (int i = 0; i < 16; ++i) ao[i] = 0.f;
#pragma unroll
        for (int ks = 0; ks < 8; ++ks) {
            const bf16x8 a = *(const LAS bf16x8*)(ST + (32 * vb + r) * 136 + ks * 16 + 8 * hh);
            const bf16x8 bq = *(const LAS bf16x8*)(QT + (32 * tb + r) * 136 + ks * 16 + 8 * hh);
            ao = MFMA32(a, bq, ao);
        }
#pragma unroll
        for (int ks = 0; ks < 4; ++ks) {
            const bf16x8 bv = *(const LAS bf16x8*)(VTT + (32 * vb + r) * 72 + ks * 16 + 8 * hh);
#pragma unroll
            for (int jb = 0; jb < 2; ++jb) { const bf16x8 a = *(const LAS bf16x8*)(KTT + (32 * (kb0 + jb) + r) * 72 + ks * 16 + 8 * hh); accS[jb] = MFMA32(a, bv, accS[jb]); }
        }
#pragma unroll
        for (int jb = 0; jb < 2; ++jb)
#pragma unroll
            for (int g = 0; g < 4; ++g) { const f32x4 el = *(const LAS f32x4*)(ELAST + 32 * (kb0 + jb) + 8 * g + 4 * hh);
#pragma unroll
                for (int j = 0; j < 4; ++j) accS[jb][4 * g + j] *= el[j]; }
        __syncthreads();
        {
            const int nks = tb ? 4 : 2;
            for (int ks = 0; ks < nks; ++ks) {
                const bf16x8 a = *(const LAS bf16x8*)(VTT + (32 * vb + r) * 72 + ks * 16 + 8 * hh);
                const bf16x8 bp = *(const LAS bf16x8*)(PP + (32 * tb + r) * 72 + ks * 16 + 8 * hh);
                ao = MFMA32(a, bp, ao);
            }
        }
        {
            float ss = 0.f;
#pragma unroll
            for (int i = 0; i < 16; ++i) ss += ao[i] * ao[i];
            ss += xor32(ss);
            if (hh == 0) RED[vb * 64 + 32 * tb + r] = ss;
        }
        __syncthreads();
        {
            const int t = 32 * tb + r;
            const float tot = RED[t] + RED[64 + t] + RED[128 + t] + RED[192 + t];
            const float rinv = __builtin_amdgcn_rsqf(tot * (1.0f / 128.0f) + EPS);
            if (t < tvalid) {
                bf16_t* op = OM + (row0 + (size_t)c * 64 + t) * 1024 + col0 + 32 * vb + 4 * hh;
#pragma unroll
                for (int g = 0; g < 4; ++g) {
                    const float x0 = ao[4 * g] * rinv * gnv[g][0] * bf_lo(gt[g].x), x1 = ao[4 * g + 1] * rinv * gnv[g][1] * bf_hi(gt[g].x);
                    const float x2 = ao[4 * g + 2] * rinv * gnv[g][2] * bf_lo(gt[g].y), x3 = ao[4 * g + 3] * rinv * gnv[g][3] * bf_hi(gt[g].y);
                    *(u32x2*)(op + 8 * g) = (u32x2){pk_bf16(x0, x1), pk_bf16(x2, x3)};
                }
            }
        }
    }
#undef HG_LOAD
#undef HG_LOADG
    {
        float* so = P.out + (path ? (layer == 0 ? O_SST0 : O_SST1) : (layer == 0 ? O_PST0 : O_PST1)) + ((size_t)(b * 6 + hd) * 128) * 128;
#pragma unroll
        for (int jb = 0; jb < 2; ++jb)
#pragma unroll
            for (int i = 0; i < 16; ++i) so[(size_t)(32 * (kb0 + jb) + 8 * (i >> 2) + 4 * hh + (i & 3)) * 128 + 32 * vb + r] = accS[jb][i];
    }
    __syncthreads();
}

__device__ __forceinline__ int grab(unsigned* ctr) {
    int u = 0;
    if ((otid() & 63) == 0) u = (int)atomicAdd(ctr, 1u);
    return __builtin_amdgcn_readfirstlane(u);
}

__device__ void conv_v(const Params& P, LAS unsigned char* lds, int widx, int wcount) {
    for (int t = widx; t < NB * 12 * 64; t += wcount) {
        const int kt = t & 63, bh = t >> 6, b = bh / 12, head = bh - b * 12;
        transpose_tile(P.in[6] + (((size_t)b * 4096 + kt * 64) * 12 + head) * 64, 768, wsb(P, OFF_VT_S) + ((size_t)bh * 64) * LS + kt * 64, LS, lds);
    }
}

__device__ void mix_a(const Params& P, LAS unsigned char* lds, int layer, unsigned* ctr, int mode, int c) {
    const int hbeg = mode ? 96 + c : (int)blockIdx.x, hend = mode ? 192 : 96, hstr = mode ? NG : (int)gridDim.x;
    for (int u = hbeg; u < hend; u += hstr) { const int path = u >= 96, v = path ? u - 96 : u; hgrn_unit(P, lds, layer, path, v / 6, v % 6); }
    if (!mode && layer == 1 && (int)blockIdx.x >= 96) conv_v(P, lds, (int)blockIdx.x - 96, (int)gridDim.x - NG - 96);
    int mnext = 4096 + c * 8 + (otid() >> 6);
    for (;;) {
        int u, lim;
        if (mode) { u = mnext; mnext += NG * 8; lim = 4096 + 64; } else { u = grab(ctr); lim = 4096; }
        if (u >= lim) break;
        mem_unit(P, layer, u);
    }
}

__device__ void mix_b(const Params& P, LAS unsigned char* lds, int layer, unsigned* ctr, int mode, int c) {
    unsigned* fsdone = ctr + 44;
    if (!mode) {
        const bool has = (int)blockIdx.x < 192;
        for (int u = blockIdx.x; u < 192; u += gridDim.x) fox_sample_unit(P, u, lds);
        if (has) {
            asm volatile("s_waitcnt vmcnt(0)" ::: "memory");
            __syncthreads();
            if (threadIdx.x == 0) { __builtin_amdgcn_fence(__ATOMIC_RELEASE, "agent"); asm volatile("s_waitcnt vmcnt(0)" ::: "memory"); (void)xb_add(fsdone, 1u); }
        }
        LAS int* slot = (LAS int*)(lds + 131072 + 2048);
        for (;;) {
            if (otid() == 0) *slot = (int)atomicAdd(ctr + 16 + layer, 1u);
            __syncthreads();
            const int u = *slot;
            __syncthreads();
            if (u >= 1536) break;
            fox_prompt_wg(P, u, lds);
        }
    }
    int mnext = 4096 + c * 8 + (otid() >> 6);
    for (;;) {
        int u, lim;
        if (mode) { u = mnext; mnext += NG * 8; lim = 4096 + 64; } else { u = grab(ctr); lim = 4096; }
        if (u >= lim) break;
        mem_unit(P, layer, u);
    }
    if (mode) {
        if (threadIdx.x == 0) { unsigned sp = 0; while (xb_ld(fsdone) < 192u) { __builtin_amdgcn_s_sleep(2); if (++sp > (1u << 22)) break; } }
    }
}

__device__ void cum_phase(const Params& P, LAS unsigned char* lds, int mode, int c) {
    const int nb = (int)gridDim.x - NG;
    const int tid = otid(), lane = tid & 63, gw = (mode ? c : (int)blockIdx.x) * 8 + (tid >> 6), nw = (mode ? NG : nb) * 8;
    for (int u = mode ? 192 + gw : gw; u < (mode ? 384 : 192); u += nw) {
        const bool smp = u >= 192; const int bh = smp ? u - 192 : u, b = bh / 12, head = bh - b * 12;
        const float* src = smp ? P.in[7] + (size_t)b * 4096 * 12 + head : P.out + O_PFL + (size_t)b * 4096 * 12 + head;
        float* dst = smp ? wsf(P, OFF_C_S) + (size_t)bh * LS : wsf(P, OFF_C_P) + (size_t)bh * 4096;
        float tot = 0.f;
        for (int i = 0; i < 64; ++i) tot += src[(size_t)(lane * 64 + i) * 12];
        float inc = tot;
#pragma unroll
        for (int o = 1; o < 64; o <<= 1) { const float x = lanex(inc, (lane - o) & 63); if (lane >= o) inc += x; }
        float run = inc - tot;
        for (int i = 0; i < 64; ++i) { run += src[(size_t)(lane * 64 + i) * 12]; dst[lane * 64 + i] = run; }
        if (smp) {
            float last = lanex(run, 63);
            if (lane == 0) { for (int t = 0; t < 16; ++t) { last += P.out[O_SFL + (size_t)(b * 16 + t) * 12 + head]; dst[4096 + t] = last; }
                for (int t = 16; t < 32; ++t) dst[4096 + t] = last; }
        }
    }
    if (mode) return;
    {
        const size_t n8 = (size_t)NB * 4096 * 768 / 8;
        for (size_t i = (size_t)blockIdx.x * 512 + tid; i < n8; i += (size_t)nb * 512) {
            const size_t e = i * 8, bt = e / 768, c = e - bt * 768, b = bt >> 12, t = bt & 4095;
            const f32x4 a = __builtin_nontemporal_load((const f32x4*)(P.in[5] + e)), bb = __builtin_nontemporal_load((const f32x4*)(P.in[5] + e + 4));
            u32x4 w; w.x = pk_bf16(a[0], a[1]); w.y = pk_bf16(a[2], a[3]); w.z = pk_bf16(bb[0], bb[1]); w.w = pk_bf16(bb[2], bb[3]);
            *(u32x4*)(wsb(P, OFF_KBUF_S) + (b * LS + t) * 768 + c) = w;
        }
    }
}

#define XB_TMO      128
#define XB_XCNT(j)  (256  + 64 * (j))
#define XB_XSUB(j)  (1280 + 64 * (j))
#define XB_XGEN(j)  (2304 + 64 * (j))
#define XB_TOP      3328
#define XB_TOPGEN   3392
#define XCD_BAR_WORDS 3456
#define XB_SPIN_CAP (1u << 18)
__device__ __forceinline__ unsigned xb_xcc_id() { return (unsigned)__builtin_amdgcn_s_getreg((3 << 11) | 20) & 0xFu; }
#define XB_SPIN(cond, bar) do { unsigned _sp = 0; while (cond) { __builtin_amdgcn_s_sleep(1); \
    if ((++_sp & 255u) == 0u) { if (xb_ld(&(bar)[XB_TMO])) break; if (_sp > XB_SPIN_CAP) { atomicAdd(&(bar)[XB_TMO], 1u); break; } } } } while (0)
struct XcdBarrier { unsigned* bar; unsigned x; volatile LAS unsigned* st; };
__device__ __forceinline__ XcdBarrier xcd_barrier_post(unsigned* bar, volatile LAS unsigned* st) {
    XcdBarrier b; b.bar = bar; b.x = xb_xcc_id(); b.st = st;
    if (threadIdx.x == 0) (void)xb_add(&bar[XB_XCNT(b.x)], 1u);
    return b;
}
__device__ __forceinline__ void xcd_barrier_complete(unsigned* bar, unsigned x, unsigned& nloc, unsigned& nx) {
    const unsigned G = gridDim.x * gridDim.y * gridDim.z;
    unsigned sum, cnt, mine, sp = 0u;
    for (;;) {
        sum = 0u; cnt = 0u; mine = 0u;
#pragma unroll
        for (unsigned j = 0; j < 16; ++j) { const unsigned c = xb_ld(&bar[XB_XCNT(j)]); sum += c; cnt += (c > 0u) ? 1u : 0u; mine = (j == x) ? c : mine; }
        if (sum == G) break;
        __builtin_amdgcn_s_sleep(1);
        if ((++sp & 255u) == 0u) { if (xb_ld(&bar[XB_TMO])) break; if (sp > XB_SPIN_CAP) { atomicAdd(&bar[XB_TMO], 1u); break; } }
    }
    nloc = mine > 0u ? mine : 1u; nx = cnt > 0u ? cnt : 1u;
}
__device__ __forceinline__ void xcd_barrier(const XcdBarrier& b) {
    asm volatile("s_waitcnt vmcnt(0)" ::: "memory");
    __syncthreads();
    if (threadIdx.x == 0) {
        unsigned* bar = b.bar;
        __builtin_amdgcn_s_waitcnt(0);
        unsigned nloc = b.st[0], nx = b.st[1];
        if (nloc == 0u) { xcd_barrier_complete(bar, b.x, nloc, nx); b.st[0] = nloc; b.st[1] = nx; }
        const unsigned old = xb_add(&bar[XB_XSUB(b.x)], 1u);
        const unsigned gen = old / nloc;
        if (old + 1u == (gen + 1u) * nloc) {
            __builtin_amdgcn_fence(__ATOMIC_RELEASE, "agent");
            asm volatile("s_waitcnt vmcnt(0)" ::: "memory");
            const unsigned og = xb_add(&bar[XB_TOP], 1u);
            const unsigned tg = og / nx;
            if (og + 1u == (tg + 1u) * nx) xb_add(&bar[XB_TOPGEN], 1u);
            else XB_SPIN(xb_ld(&bar[XB_TOPGEN]) == tg, bar);
            __builtin_amdgcn_fence(__ATOMIC_ACQUIRE, "agent");
            xb_add(&bar[XB_XGEN(b.x)], 1u);
            asm volatile("s_waitcnt vmcnt(0)" ::: "memory");
        } else {
            XB_SPIN(xb_ld(&bar[XB_XGEN(b.x)]) == gen, bar);
            __builtin_amdgcn_fence(__ATOMIC_ACQUIRE, "agent");
            asm volatile("s_waitcnt vmcnt(0)" ::: "memory");
        }
    }
    __syncthreads();
}

__device__ __forceinline__ void sub_barrier(unsigned* cnt) {
    asm volatile("s_waitcnt vmcnt(0)" ::: "memory");
    __syncthreads();
    if (threadIdx.x == 0) {
        __builtin_amdgcn_fence(__ATOMIC_RELEASE, "agent"); asm volatile("s_waitcnt vmcnt(0)" ::: "memory");
        const unsigned old = xb_add(cnt, 1u), target = (old / NG + 1u) * NG;
        unsigned sp = 0; while (xb_ld(cnt) < target) { __builtin_amdgcn_s_sleep(1); if (++sp > (1u << 22)) break; }
        __builtin_amdgcn_fence(__ATOMIC_ACQUIRE, "agent"); asm volatile("s_waitcnt vmcnt(0)" ::: "memory");
    }
    __syncthreads();
}
#define EN(kind, who, bar, code, layer) ((kind) | ((who) << 3) | ((bar) << 5) | ((code) << 7) | ((layer) << 10))
constexpr int NEN = 50;
__constant__ unsigned short PROG[NEN] = {
    EN(0, 0, 1, 0, 0), EN(1, 0, 0, 0, 0), EN(1, 0, 1, 1, 0),
    EN(2, 1, 0, 0, 0), EN(1, 2, 2, 0, 0), EN(2, 2, 2, 0, 0), EN(1, 2, 2, 2, 0), EN(1, 2, 2, 3, 0), EN(1, 2, 2, 4, 0), EN(1, 2, 0, 0, 1), EN(2, 3, 1, 0, 0),
    EN(1, 0, 1, 2, 0), EN(1, 0, 1, 3, 0), EN(1, 0, 1, 4, 0), EN(1, 0, 1, 0, 1),
    EN(2, 1, 0, 0, 1), EN(2, 2, 2, 0, 1), EN(1, 2, 2, 2, 1), EN(1, 2, 2, 3, 1), EN(1, 2, 0, 4, 1), EN(2, 3, 1, 0, 1),
    EN(1, 0, 1, 2, 1), EN(1, 0, 1, 3, 1), EN(1, 0, 1, 4, 1), EN(1, 0, 0, 5, 1), EN(1, 0, 1, 6, 2),
    EN(4, 1, 0, 0, 0), EN(1, 2, 0, 5, 1), EN(1, 2, 2, 6, 2), EN(4, 2, 1, 0, 0),
    EN(3, 1, 0, 0, 2), EN(3, 2, 2, 0, 2), EN(1, 2, 2, 2, 2), EN(1, 2, 2, 3, 2), EN(1, 2, 2, 4, 2), EN(1, 2, 0, 6, 3), EN(3, 3, 1, 0, 2),
    EN(1, 0, 1, 2, 2), EN(1, 0, 1, 3, 2), EN(1, 0, 1, 4, 2), EN(1, 0, 1, 6, 3),
    EN(3, 1, 0, 0, 3), EN(3, 2, 2, 0, 3), EN(1, 2, 2, 2, 3), EN(1, 2, 2, 3, 3), EN(1, 2, 0, 4, 3), EN(3, 3, 1, 0, 3),
    EN(1, 0, 1, 2, 3), EN(1, 0, 1, 3, 3), EN(1, 0, 0, 4, 3) };

__global__ void __launch_bounds__(512, 2) yoco_fwd(const Params P) {
    extern __shared__ __attribute__((aligned(16))) unsigned char shm[];
    LAS unsigned char* lds = (LAS unsigned char*)shm;
    cg::grid_group grid = cg::this_grid();
    unsigned* ctr = (unsigned*)(P.ws + OFF_CTR);
    volatile LAS unsigned* xst = (volatile LAS unsigned*)(lds + 131072 + 4096);
    if (threadIdx.x == 0) { xst[0] = 0u; xst[1] = 0u; }
    __syncthreads();
    XcdBarrier xb; xb.bar = (unsigned*)(P.ws + OFF_XBAR); xb.x = 0; xb.st = xst;
    const int bid = blockIdx.x, G = gridDim.x, gc = bid - (G - NG);
    const bool ingroup = gc >= 0;
#pragma nounroll
    for (int e = 0; e < NEN; ++e) {
        const unsigned en = PROG[e]; const int kind = en & 7, who = (en >> 3) & 3, bar = (en >> 5) & 3, code = (en >> 7) & 7, l = (en >> 10) & 3;
        const bool mine = who == 0 || (who == 1 && !ingroup) || (who >= 2 && ingroup);
#ifdef DUP_IN
        const int nrep = (kind == 1 && who == 0 && (code == 0 || code == 5 || code == 6)) ? 2 : 1;
#else
        const int nrep = 1;
#endif
#pragma nounroll
        for (int rep = 0; rep < nrep; ++rep)
        if (mine) {
            const int smp = who == 2;
            if (kind == 0) { prep_weights(P, lds); prep_rows(P); prep_misc(P, lds); }
            else if (kind == 1) {
                const bf16_t* A = wsb(P, OFF_H); const bf16_t* Bt; int M = smp ? 256 : MPR, N = 1024, K = 1024, mode;
                switch (code) {
                    case 0: Bt = wsb(P, OFF_WINA + (size_t)l * SZ_WINA); N = 3328; mode = M_INA; break;
                    case 1: A = wsb(P, OFF_MEMB); Bt = wsb(P, OFF_WMEM); M = 4096; N = 2048; mode = M_MEMKV; break;
                    case 2: A = outb(P, DO_OMIX); Bt = w_out_ptr(P, l); mode = M_OUT; break;
                    case 3: Bt = w_up_ptr(P, l); N = 5632; mode = M_UP; break;
                    case 4: A = act_ptr(P, l); Bt = w_dn_ptr(P, l); K = 2816; mode = (l == 3) ? M_FINAL : M_OUT; break;
                    case 5: Bt = wsb(P, OFF_WKV); N = 1792; mode = M_KV; break;
                    default: Bt = wsb(P, OFF_WINB + (size_t)(l - 2) * SZ_W1K); mode = M_INB; break;
                }
                const int rowbase = smp ? MPR : 0;
                const int cs = (code == 6 && l == 2) ? (gc + NG - 7) % NG : gc;
                run_gemm(P, lds, A + (size_t)rowbase * K, Bt, M, N, K, mode, l, smp ? NG : G, smp ? cs : bid, rowbase);
            }
            else if (kind == 2) mix_a(P, lds, l, ctr + l, smp, gc);
            else if (kind == 3) mix_b(P, lds, l, ctr + l, smp, gc);
            else cum_phase(P, lds, smp, gc);
        }
        if (bar == 1) { if (e == 0) { grid.sync(); xb = xcd_barrier_post((unsigned*)(P.ws + OFF_XBAR), xst); } else xcd_barrier(xb); }
        else if (bar == 2 && ingroup) sub_barrier(ctr + 40);
    }
}

extern "C" void kernel_launch(void* const* d_in, const int* in_sizes, int n_in, void* d_out, int out_size, void* d_ws, size_t ws_size, hipStream_t stream) {
    static int grid = 0;
    if (grid == 0) {
        int dev = 0, cus = 0, per_cu = 0;
        hipGetDevice(&dev);
        hipDeviceGetAttribute(&cus, hipDeviceAttributeMultiprocessorCount, dev);
        hipFuncSetAttribute((const void*)yoco_fwd, hipFuncAttributeMaxDynamicSharedMemorySize, LDS_BYTES);
        hipOccupancyMaxActiveBlocksPerMultiprocessor(&per_cu, (const void*)yoco_fwd, 512, LDS_BYTES);
        if (per_cu < 1) per_cu = 1;
        (void)hipGetLastError();
        grid = cus * 1;
        if (ws_size < WS_END) fprintf(stderr, "kernel_launch: workspace too small (%zu < %zu)\n", ws_size, (size_t)WS_END);
    }
    Params p{};
    for (int i = 0; i < 28; ++i) p.in[i] = (const float*)d_in[i];
    p.out = (float*)d_out; p.ws = (unsigned char*)d_ws;
    unsigned char* ws = (unsigned char*)d_ws;
    int j = 0;
    auto add = [&](const float* W, const float* gain, size_t off, int K, int Ntrue, int Np, int kind) { p.wj[j].W = W; p.wj[j].gain = gain; p.wj[j].Bt = (bf16_t*)(ws + off); p.wj[j].K = K; p.wj[j].Ntrue = Ntrue; p.wj[j].Np = Np; p.wj[j].kind = kind; ++j; };
    for (int l = 0; l < 2; ++l) add(p.in[11] + (size_t)l * 1024 * 3328, p.in[10] + l * 1024, OFF_WINA + l * SZ_WINA, 1024, 3328, 3328, 2);
    for (int l = 0; l < 2; ++l) add(p.in[14] + (size_t)l * 1024 * 1024, p.in[10] + (2 + l) * 1024, OFF_WINB + l * SZ_W1K, 1024, 1024, 1024, 1);
    add(p.in[17], p.in[16], OFF_WKV, 1024, 1548, 1792, 4);
    for (int l = 0; l < 4; ++l) add(p.in[21] + (size_t)l * 1024 * 512, p.in[20] + l * 1024, OFF_WMEM + (size_t)l * 512 * 1024 * 2, 1024, 512, 512, 5);
    for (int l = 0; l < 4; ++l) add(p.in[24] + (size_t)l * 1024 * 1024, nullptr, l < 2 ? OFF_WOUT01 + l * SZ_W1K : OFF_WOUT23 + (l - 2) * SZ_W1K, 1024, 1024, 1024, 0);
    for (int l = 0; l < 4; ++l) add(p.in[26] + (size_t)l * 1024 * 5632, p.in[25] + l * 1024, l < 2 ? OFF_WUP01 + l * SZ_WUP : OFF_WUP23 + (l - 2) * SZ_WUP, 1024, 5632, 5632, 3);
    for (int l = 0; l < 4; ++l) add(p.in[27] + (size_t)l * 2816 * 1024, nullptr, l < 2 ? OFF_WDN01 + l * SZ_WDN : OFF_WDN23 + (l - 2) * SZ_WDN, 2816, 1024, 1024, 0);
    void* args[] = {&p};
    hipError_t e = hipLaunchCooperativeKernel((const void*)yoco_fwd, dim3(grid), dim3(512), args, LDS_BYTES, stream);
    if (e != hipSuccess) fprintf(stderr, "cooperative launch failed: %s (grid %d)\n", hipGetErrorString(e), grid);
}
```
